# Optimizing an MI355X kernel written in HIP

```python
import jax, jax.numpy as jnp
from jax import lax
import numpy as np

D_MODEL = 2048
BATCH = 4
SEQ = 2048
DEPTH = 4

HEAD_DIM = 128
N_HEADS = D_MODEL // HEAD_DIM
N_SB_HEADS = N_HEADS // 2
N_FOX_HEADS = N_HEADS - N_SB_HEADS
Q_BLOCK = 128
POOL_WINDOWS = (2, 4, 8, 16)
N_POOL_GROUPS = len(POOL_WINDOWS)
POOL_GROUP = D_MODEL // N_POOL_GROUPS
D_FF = ((int(8 * D_MODEL / 3) + 255) // 256) * 256
CONV_WIDTH = 3
N_MOD = 6
EPS = 1e-6
N_ATTN_LAYERS = (DEPTH + 1) // 2
N_POOL_LAYERS = DEPTH // 2

kernel_name = "stickbreak_fox_pool_convffn_adaln"


def rms_norm(x, gain):
    xf = x.astype(jnp.float32)
    y = xf * lax.rsqrt(jnp.mean(xf * xf, axis=-1, keepdims=True) + EPS)
    return (y * gain.astype(jnp.float32)).astype(x.dtype)


def modulate(h, shift, scale):
    return h * (1.0 + scale[:, None, :]) + shift[:, None, :]


def attention_mixer(h, w_in, b_forget, w_out):
    B, S, D = h.shape
    proj = h @ w_in
    qkv = proj[..., :3 * D].reshape(B, S, 3, N_HEADS, HEAD_DIM)
    q = qkv[:, :, 0].transpose(0, 2, 1, 3)
    k = qkv[:, :, 1].transpose(0, 2, 1, 3)
    v = qkv[:, :, 2].transpose(0, 2, 1, 3)
    f_logit = proj[..., 3 * D:].astype(jnp.float32) + b_forget.astype(jnp.float32)
    F = jnp.cumsum(jax.nn.log_sigmoid(f_logit), axis=1).transpose(0, 2, 1)
    nb = S // Q_BLOCK
    q_blocks = q.reshape(B, N_HEADS, nb, Q_BLOCK, HEAD_DIM).transpose(2, 0, 1, 3, 4)
    F_blocks = F.reshape(B, N_FOX_HEADS, nb, Q_BLOCK).transpose(2, 0, 1, 3)
    starts = jnp.arange(nb, dtype=jnp.int32) * Q_BLOCK
    s_idx = jnp.arange(S)
    v_sb, v_fx = v[:, :N_SB_HEADS], v[:, N_SB_HEADS:]
    scale = HEAD_DIM ** -0.5

    def block(args):
        qb, Fq, start = args
        t_idx = start + jnp.arange(Q_BLOCK)
        z = jnp.einsum('bhqd,bhkd->bhqk', qb, k).astype(jnp.float32) * scale
        z_sb, z_fx = z[:, :N_SB_HEADS], z[:, N_SB_HEADS:]
        strict = s_idx[None, :] < t_idx[:, None]
        log_rest = jnp.where(strict, jax.nn.log_sigmoid(-z_sb), 0.0)
        log_after = lax.cumsum(log_rest, axis=3, reverse=True) - log_rest
        w_sb = jnp.where(strict, jnp.exp(jax.nn.log_sigmoid(z_sb) + log_after), 0.0)
        o_sb = jnp.einsum('bhqk,bhkd->bhqd', w_sb.astype(v.dtype), v_sb)
        causal = s_idx[None, :] <= t_idx[:, None]
        logits = z_fx + Fq[..., :, None] - F[:, :, None, :]
        p = jax.nn.softmax(jnp.where(causal, logits, -jnp.inf), axis=-1)
        o_fx = jnp.einsum('bhqk,bhkd->bhqd', p.astype(v.dtype), v_fx)
        return jnp.concatenate([o_sb, o_fx], axis=1)

    out = lax.map(block, (q_blocks, F_blocks, starts))
    out = out.transpose(1, 0, 3, 2, 4).reshape(B, S, D)
    return out @ w_out


def pool_mixer(h, w_pool, pool_scale):
    B, S, D = h.shape
    hf = h.astype(jnp.float32).reshape(B, S, N_POOL_GROUPS, POOL_GROUP)
    cs = jnp.cumsum(hf, axis=1)
    pos = jnp.arange(S)
    diffs = []
    for g, w in enumerate(POOL_WINDOWS):
        c_g = cs[:, :, g]
        lagged = jnp.pad(c_g, ((0, 0), (w, 0), (0, 0)))[:, :S]
        count = jnp.minimum(pos + 1, w).astype(jnp.float32)[None, :, None]
        diffs.append((c_g - lagged) / count - hf[:, :, g])
    d = jnp.stack(diffs, axis=2).astype(h.dtype)
    y = jnp.einsum('bsgc,gce->bsge', d, w_pool).reshape(B, S, D)
    return y * pool_scale


def conv_ffn(h, w_up, conv_w, conv_b, w_down):
    S = h.shape[1]
    u = h @ w_up
    up = jnp.pad(u, ((0, 0), (CONV_WIDTH - 1, 0), (0, 0)))
    y = conv_b
    for i in range(CONV_WIDTH):
        y = y + up[:, i:i + S] * conv_w[i]
    a, g = jnp.split(y, 2, axis=-1)
    return (jax.nn.silu(g) * a) @ w_down


def setup_inputs(seed: int = 0) -> dict:
    key = jax.random.key(seed)
    ks = jax.random.split(key, 16)
    n = jax.random.normal
    D, F2 = D_MODEL, 2 * D_FF
    return {
        "x": n(ks[0], (BATCH, SEQ, D), jnp.float32),
        "c": n(ks[1], (BATCH, D), jnp.float32),
        "w_mod": n(ks[2], (DEPTH, D, N_MOD * D), jnp.float32) * (0.5 * D ** -0.5),
        "b_mod": n(ks[3], (DEPTH, N_MOD * D), jnp.float32) * 0.02,
        "norm_gain": 1.0 + 0.1 * n(ks[4], (DEPTH, 2, D), jnp.float32),
        "w_attn_in": n(ks[5], (N_ATTN_LAYERS, D, 3 * D + N_FOX_HEADS), jnp.float32) * D ** -0.5,
        "b_forget": jax.random.uniform(ks[6], (N_ATTN_LAYERS, N_FOX_HEADS), jnp.float32, 1.0, 4.0),
        "w_attn_out": n(ks[7], (N_ATTN_LAYERS, D, D), jnp.float32) * D ** -0.5,
        "w_pool": n(ks[8], (N_POOL_LAYERS, N_POOL_GROUPS, POOL_GROUP, POOL_GROUP), jnp.float32) * POOL_GROUP ** -0.5,
        "pool_scale": 1.0 + 0.1 * n(ks[9], (N_POOL_LAYERS, D), jnp.float32),
        "w_up": n(ks[10], (DEPTH, D, F2), jnp.float32) * D ** -0.5,
        "conv_w": n(ks[11], (DEPTH, CONV_WIDTH, F2), jnp.float32) * CONV_WIDTH ** -0.5,
        "conv_b": n(ks[12], (DEPTH, F2), jnp.float32) * 0.02,
        "w_down": n(ks[13], (DEPTH, D_FF, D), jnp.float32) * D_FF ** -0.5,
        "final_gain": 1.0 + 0.1 * n(ks[14], (D,), jnp.float32),
    }


def reference(x, c, w_mod, b_mod, norm_gain, w_attn_in, b_forget, w_attn_out, w_pool, pool_scale,
              w_up, conv_w, conv_b, w_down, final_gain):
    cond = jax.nn.silu(c)
    for l in range(DEPTH):
        mod = cond @ w_mod[l] + b_mod[l]
        sh1, sc1, g1, sh2, sc2, g2 = jnp.split(mod, N_MOD, axis=-1)
        h = modulate(rms_norm(x, norm_gain[l, 0]), sh1, sc1)
        i = l // 2
        if l % 2 == 0:
            y = attention_mixer(h, w_attn_in[i], b_forget[i], w_attn_out[i])
        else:
            y = pool_mixer(h, w_pool[i], pool_scale[i])
        x = x + g1[:, None, :] * y
        h = modulate(rms_norm(x, norm_gain[l, 1]), sh2, sc2)
        x = x + g2[:, None, :] * conv_ffn(h, w_up[l], conv_w[l], conv_b[l], w_down[l])
    return rms_norm(x, final_gain)
```

```cpp
#include <hip/hip_runtime.h>
#include <cstdio>
#include <cstdint>

#ifndef MK_N_LAUNCHES
#define MK_N_LAUNCHES 0
#endif

constexpr int BATCH = 4, SEQ = 2048, DM = 2048, DEPTH = 4, NH = 16, HD = 128, NSB = 8, NFX = 8;
constexpr int M = BATCH * SEQ;
constexpr int DFF = 5632, F2 = 2 * DFF;
constexpr int NQKV = 3 * DM;
constexpr int NIN = NQKV + NFX;
constexpr int NMOD = 6 * DM;
constexpr float EPS = 1e-6f;
constexpr float LOG2E = 1.4426950408889634f;
constexpr float ATT_SCALE = 0.08838834764831845f;
constexpr float SB_EXIT = 1e-24f;

namespace pg8 {
#define PG8_LAS __attribute__((address_space(3)))
typedef unsigned short bf16_t;
typedef short bf16x8 __attribute__((ext_vector_type(8)));
typedef float f32x4 __attribute__((ext_vector_type(4)));
typedef unsigned u32x4 __attribute__((ext_vector_type(4)));
constexpr int BM = 256, BK = 64, HALF = 128, HTB = HALF * BK * 2, STAGE_BYTES = 8 * HTB, NXCD = 8, WGM = 8;

__host__ __device__ __forceinline__ int lds_byte(int r, int c) { const int st = (r >> 4) * 2 + (c >> 5), rr = r & 15, cc = c & 31, ob = rr * 64 + cc * 2; return st * 1024 + (ob ^ (((ob >> 9) & 1) << 5)); }
__host__ __device__ __forceinline__ void stage_rc(int b, int& R, int& C) { const int st = b / 1024, sb = b % 1024, swz = sb ^ (((sb >> 9) & 1) << 5); R = (st >> 1) * 16 + swz / 64; C = (st & 1) * 32 + (swz % 64) / 2; }
__host__ __device__ __forceinline__ int perm32(int rho) { const int n = rho >> 4, i = rho & 15; return 8 * (i >> 2) + 4 * n + (i & 3); }

struct Unit { int pm, pn; };
struct Gemm { const bf16_t* A; const bf16_t* Bt; int M, N, K, lda, grouped; };

struct StaticOrder {
    int nM, nN, nwg, G, c;
    __host__ __device__ void init(int M_, int N_, int G_, int c_) { nM = M_ / BM; nN = N_ / BM; nwg = nM * nN; G = G_; c = c_; }
    __host__ __device__ bool next(int i, Unit& u) const {
        const long L = (long)i * G + c; if (L >= nwg) return false;
        int wgid = (int)L; { const int q = nwg / NXCD, r = nwg % NXCD, xcd = wgid % NXCD, off = wgid / NXCD; wgid = (xcd < r ? xcd * (q + 1) : r * (q + 1) + (xcd - r) * q) + off; }
        const int nig = WGM * nN, gid = wgid / nig, fm = gid * WGM, gsz = (nM - fm) < WGM ? (nM - fm) : WGM;
        u.pm = fm + ((wgid % nig) % gsz); u.pn = (wgid % nig) / gsz; return true;
    }
    __device__ __forceinline__ void a_ready(const Unit&) const {}
    __device__ __forceinline__ void done(const Unit&) const {}
};

__device__ __forceinline__ unsigned cvt_pk_bf16(float lo, float hi) { unsigned r; asm volatile("v_cvt_pk_bf16_f32 %0, %1, %2" : "=v"(r) : "v"(lo), "v"(hi)); return r; }

struct EpiBf16 {
    static constexpr bool PERM = true, AFTER_DRAIN = false;
    bf16_t* O; int ldc; int split_cols; size_t split_stride;
    __device__ __forceinline__ void operator()(const f32x4 (&acc)[2][2][4][2], const Unit& u, int wr, int wc, int fr, int fq) const {
        const int row0 = u.pm * BM + wr * 64 + fr; int colt = u.pn * BM; bf16_t* base = O;
        if (split_cols) { const int t = colt / split_cols; base += (size_t)t * split_stride; colt -= t * split_cols; }
        const int col0 = colt + wc * 32 + 8 * fq;
#pragma unroll
        for (int ai = 0; ai < 2; ++ai)
#pragma unroll
            for (int m = 0; m < 4; ++m) { bf16_t* rowp = base + (size_t)(row0 + ai * HALF + m * 16) * ldc + col0;
#pragma unroll
                for (int bj = 0; bj < 2; ++bj) { const f32x4 v0 = acc[ai][bj][m][0], v1 = acc[ai][bj][m][1];
                    u32x4 w; w.x = cvt_pk_bf16(v0[0], v0[1]); w.y = cvt_pk_bf16(v0[2], v0[3]); w.z = cvt_pk_bf16(v1[0], v1[1]); w.w = cvt_pk_bf16(v1[2], v1[3]);
                    *(u32x4*)(rowp + bj * HALF) = w; } }
    }
};
struct EpiResid {
    static constexpr bool PERM = false, AFTER_DRAIN = false;
    const float* xin; float* xout; const float* gate; const float* pscale;
    __device__ __forceinline__ void operator()(const f32x4 (&acc)[2][2][4][2], const Unit& u, int wr, int wc, int fr, int fq) const {
        const int row0 = u.pm * BM + wr * 64 + fr, col0 = u.pn * BM + wc * 32 + 4 * fq; const int b = u.pm >> 3;
        f32x4 gv[2][2];
#pragma unroll
        for (int bj = 0; bj < 2; ++bj)
#pragma unroll
            for (int n = 0; n < 2; ++n) { gv[bj][n] = *(const f32x4*)(gate + (size_t)b * NMOD + col0 + bj * HALF + n * 16);
                if (pscale) gv[bj][n] = gv[bj][n] * *(const f32x4*)(pscale + col0 + bj * HALF + n * 16); }
#pragma unroll
        for (int ai = 0; ai < 2; ++ai)
#pragma unroll
            for (int m = 0; m < 4; ++m) { const size_t off = (size_t)(row0 + ai * HALF + m * 16) * DM + col0;
#pragma unroll
                for (int bj = 0; bj < 2; ++bj)
#pragma unroll
                    for (int n = 0; n < 2; ++n) { const f32x4 xv = *(const f32x4*)(xin + off + bj * HALF + n * 16);
                        *(f32x4*)(xout + off + bj * HALF + n * 16) = xv + gv[bj][n] * acc[ai][bj][m][n]; }
                asm volatile("" ::: "memory"); }
    }
};

template <class Epi, class Sched, bool ALIGN_EPI = false, bool SP2 = false>
__device__ __forceinline__ void gemm_phase(PG8_LAS unsigned char* lds, const Gemm g, const Sched& S, const Epi& E, const int tid) {
    const int wid = __builtin_amdgcn_readfirstlane(tid >> 6), lane = tid & 63, wr = wid >> 2, wc = wid & 3, fr = lane & 15, fq = lane >> 4;
    const int K = g.K, nt = K / BK, lda = g.lda;
    unsigned voffA[2], voffB[2];
#pragma unroll
    for (int i = 0; i < 2; ++i) { int R, C; stage_rc(tid * 16 + i * 8192, R, C); const int Rb = Epi::PERM ? ((R & ~31) + perm32(R & 31)) : R;
        voffA[i] = (unsigned)(R * lda + C) * 2u; voffB[i] = (unsigned)(Rb * K + C) * 2u; }
    const size_t kstep = (size_t)(BK * 2);
    const size_t hstepA = (size_t)HALF * lda * 2, hstepB = (size_t)HALF * K * 2;
    const size_t tstepA = 2 * hstepA, tstepB = 2 * hstepB;
    const unsigned ldsw = (unsigned)wid * 1024u;
    const int aoff = lds_byte(wr * 64 + fr, fq * 8), boff = lds_byte(wc * 32 + fr, fq * 8);
#define PG8_UA(u) ((const char*)g.A + (size_t)(u).pm * tstepA + (g.grouped ? (size_t)((u).pn >> 1) * (size_t)K * 2 : (size_t)0))
#define PG8_UB(u) ((const char*)g.Bt + (size_t)(u).pn * tstepB)
#define PG8_SA(b, h) (((b) * 2 + (h)) * HTB)
#define PG8_SB(b, h) ((4 + (b) * 2 + (h)) * HTB)
#define PG8_STAGE(bufoff, gbase, voff) do { _Pragma("unroll") for (int _i = 0; _i < 2; ++_i) \
        __builtin_amdgcn_global_load_lds((const unsigned*)((const char*)(gbase) + (voff)[_i]), (PG8_LAS unsigned*)(lds + (bufoff) + ldsw + _i * 8192), 16, 0, 0); } while (0)
#define PG8_LDA(dst, b, h) do { _Pragma("unroll") for (int m = 0; m < 4; ++m) _Pragma("unroll") for (int k = 0; k < 2; ++k) dst[m][k] = *(const PG8_LAS bf16x8*)(lds + PG8_SA(b, h) + aoff + m * 2048 + k * 1024); } while (0)
#define PG8_LDB(dst, b, h) do { _Pragma("unroll") for (int n = 0; n < 2; ++n) _Pragma("unroll") for (int k = 0; k < 2; ++k) dst[n][k] = *(const PG8_LAS bf16x8*)(lds + PG8_SB(b, h) + boff + n * 2048 + k * 1024); } while (0)
#define PG8_MMA(ai, bj, At, Bt) do { __builtin_amdgcn_s_setprio(1); _Pragma("unroll") for (int m = 0; m < 4; ++m) _Pragma("unroll") for (int n = 0; n < 2; ++n) _Pragma("unroll") for (int k = 0; k < 2; ++k) \
        acc[ai][bj][m][n] = __builtin_amdgcn_mfma_f32_16x16x32_bf16(Bt[n][k], At[m][k], acc[ai][bj][m][n], 0, 0, 0); __builtin_amdgcn_s_setprio(0); } while (0)
#define PG8_WAIT_V(n) asm volatile("s_waitcnt vmcnt(" #n ")" ::: "memory")
#define PG8_WAIT_L(n) asm volatile("s_waitcnt lgkmcnt(" #n ")" ::: "memory")
#define PG8_BAR __builtin_amdgcn_s_barrier()
#define PG8_SCHED __builtin_amdgcn_sched_barrier(0)
    Unit cur, nxt; int ui = 0;
    if (!S.next(0, cur)) return;
    f32x4 acc[2][2][4][2];
#pragma unroll
    for (int a = 0; a < 2; ++a)
#pragma unroll
        for (int b = 0; b < 2; ++b)
#pragma unroll
            for (int m = 0; m < 4; ++m)
#pragma unroll
                for (int n = 0; n < 2; ++n) acc[a][b][m][n] = (f32x4){0.f, 0.f, 0.f, 0.f};
    bf16x8 At[4][2], B0[2][2], B1[2][2];
    const char* cA = PG8_UA(cur); const char* cB = PG8_UB(cur);
    S.a_ready(cur);
    if constexpr (SP2) {
        PG8_STAGE(PG8_SB(0, 0), cB, voffB); PG8_STAGE(PG8_SB(0, 1), cB + hstepB, voffB); PG8_STAGE(PG8_SA(0, 0), cA, voffA); PG8_STAGE(PG8_SA(0, 1), cA + hstepA, voffA);
        if (wr == 1) PG8_BAR;
        PG8_WAIT_V(2); PG8_BAR;
        PG8_STAGE(PG8_SB(1, 0), cB + kstep, voffB); PG8_STAGE(PG8_SA(1, 0), cA + kstep, voffA); PG8_STAGE(PG8_SB(1, 1), cB + hstepB + kstep, voffB);
        PG8_WAIT_V(6); PG8_BAR;
    } else {
        PG8_STAGE(PG8_SB(0, 0), cB, voffB); PG8_STAGE(PG8_SA(0, 0), cA, voffA); PG8_STAGE(PG8_SB(0, 1), cB + hstepB, voffB); PG8_STAGE(PG8_SA(0, 1), cA + hstepA, voffA);
        if (wr == 1) PG8_BAR;
        PG8_WAIT_V(4); PG8_BAR;
        PG8_STAGE(PG8_SB(1, 0), cB + kstep, voffB); PG8_STAGE(PG8_SA(1, 0), cA + kstep, voffA); PG8_STAGE(PG8_SB(1, 1), cB + hstepB + kstep, voffB);
        PG8_WAIT_V(6); PG8_BAR;
    }
    for (;;) {
        const bool has_next = S.next(ui + 1, nxt);
        const char* nA = has_next ? PG8_UA(nxt) : cA; const char* nB = has_next ? PG8_UB(nxt) : cB;
        for (int t = 0; t < nt; t += 2) {
            const bool last = (t == nt - 2);
            const char* a1 = cA + (size_t)(t + 1) * kstep;
            const char* a2 = last ? nA : cA + (size_t)(t + 2) * kstep; const char* b2 = last ? nB : cB + (size_t)(t + 2) * kstep;
            const char* a3 = a2 + kstep; const char* b3 = b2 + kstep;
            if (last && has_next) S.a_ready(nxt);
            if constexpr (SP2) {
            PG8_LDB(B0, 0, 0); PG8_LDB(B1, 0, 1); PG8_SCHED; PG8_LDA(At, 0, 0); PG8_STAGE(PG8_SA(1, 1), a1 + hstepA, voffA);
            PG8_WAIT_V(8); PG8_WAIT_L(0); PG8_BAR; PG8_MMA(0, 0, At, B0); PG8_MMA(0, 1, At, B1); PG8_BAR; PG8_SCHED;
            PG8_LDA(At, 0, 1); PG8_STAGE(PG8_SB(0, 0), b2, voffB); PG8_STAGE(PG8_SB(0, 1), b2 + hstepB, voffB); PG8_STAGE(PG8_SA(0, 0), a2, voffA);
            PG8_WAIT_V(8); PG8_WAIT_L(0); PG8_BAR; PG8_MMA(1, 0, At, B0); PG8_MMA(1, 1, At, B1); PG8_BAR; PG8_SCHED;
            PG8_LDB(B0, 1, 0); PG8_LDB(B1, 1, 1); PG8_SCHED; PG8_LDA(At, 1, 0); PG8_STAGE(PG8_SA(0, 1), a2 + hstepA, voffA);
            PG8_WAIT_V(8); PG8_WAIT_L(0); PG8_BAR; PG8_MMA(0, 0, At, B0); PG8_MMA(0, 1, At, B1); PG8_BAR; PG8_SCHED;
            PG8_LDA(At, 1, 1); PG8_STAGE(PG8_SB(1, 0), b3, voffB); PG8_STAGE(PG8_SB(1, 1), b3 + hstepB, voffB); PG8_STAGE(PG8_SA(1, 0), a3, voffA);
            PG8_WAIT_V(8); PG8_WAIT_L(0); PG8_BAR; PG8_MMA(1, 0, At, B0); PG8_MMA(1, 1, At, B1); PG8_BAR; PG8_SCHED;
            } else {
            PG8_LDB(B0, 0, 0); PG8_SCHED; PG8_LDA(At, 0, 0); PG8_STAGE(PG8_SA(1, 1), a1 + hstepA, voffA);
            PG8_WAIT_L(8); PG8_BAR; PG8_WAIT_L(0); PG8_MMA(0, 0, At, B0); PG8_BAR; PG8_SCHED;
            PG8_LDB(B1, 0, 1); PG8_STAGE(PG8_SB(0, 0), b2, voffB);
            PG8_BAR; PG8_WAIT_L(0); PG8_MMA(0, 1, At, B1); PG8_BAR;
            PG8_LDA(At, 0, 1); PG8_STAGE(PG8_SA(0, 0), a2, voffA);
            PG8_BAR; PG8_WAIT_L(0); PG8_MMA(1, 0, At, B0); PG8_BAR; PG8_SCHED;
            PG8_STAGE(PG8_SB(0, 1), b2 + hstepB, voffB);
            PG8_WAIT_V(6); PG8_BAR; PG8_MMA(1, 1, At, B1); PG8_BAR;
            PG8_LDB(B0, 1, 0); PG8_SCHED; PG8_LDA(At, 1, 0); PG8_STAGE(PG8_SA(0, 1), a2 + hstepA, voffA);
            PG8_WAIT_L(8); PG8_BAR; PG8_WAIT_L(0); PG8_MMA(0, 0, At, B0); PG8_BAR; PG8_SCHED;
            PG8_LDB(B1, 1, 1); PG8_STAGE(PG8_SB(1, 0), b3, voffB);
            PG8_BAR; PG8_WAIT_L(0); PG8_MMA(0, 1, At, B1); PG8_BAR;
            PG8_LDA(At, 1, 1); PG8_STAGE(PG8_SA(1, 0), a3, voffA);
            PG8_BAR; PG8_WAIT_L(0); PG8_MMA(1, 0, At, B0); PG8_BAR; PG8_SCHED;
            PG8_STAGE(PG8_SB(1, 1), b3 + hstepB, voffB);
            PG8_WAIT_V(6); PG8_BAR; PG8_MMA(1, 1, At, B1); PG8_BAR;
            }
        }
        if constexpr (ALIGN_EPI) { if (wr == 0) PG8_BAR; }
        if constexpr (!Epi::AFTER_DRAIN) { E(acc, cur, wr, wc, fr, fq); S.done(cur); }
        if (!has_next) break;
#pragma unroll
        for (int a = 0; a < 2; ++a)
#pragma unroll
            for (int b = 0; b < 2; ++b)
#pragma unroll
                for (int m = 0; m < 4; ++m)
#pragma unroll
                    for (int n = 0; n < 2; ++n) acc[a][b][m][n] = (f32x4){0.f, 0.f, 0.f, 0.f};
        cur = nxt; cA = nA; cB = nB; ++ui;
        if constexpr (ALIGN_EPI) { if (wr == 1) PG8_BAR; }
    }
    PG8_WAIT_V(0);
    if constexpr (!ALIGN_EPI) { if (wr == 0) PG8_BAR; }
    PG8_BAR;
#undef PG8_UA
#undef PG8_UB
#undef PG8_SA
#undef PG8_SB
#undef PG8_STAGE
#undef PG8_LDA
#undef PG8_LDB
#undef PG8_MMA
#undef PG8_WAIT_V
#undef PG8_WAIT_L
#undef PG8_BAR
#undef PG8_SCHED
}
}

#define GAS __attribute__((address_space(1)))
#define LAS __attribute__((address_space(3)))
typedef unsigned short bf16;
typedef unsigned v4u __attribute__((ext_vector_type(4)));
typedef unsigned v2u __attribute__((ext_vector_type(2)));
typedef float f32x4 __attribute__((ext_vector_type(4)));
typedef float f32x16 __attribute__((ext_vector_type(16)));
typedef short bf16x8 __attribute__((ext_vector_type(8)));
typedef short s16x4 __attribute__((ext_vector_type(4)));
typedef GAS unsigned gu32;
#define RLX_AGENT __ATOMIC_RELAXED, __HIP_MEMORY_SCOPE_AGENT
#define LDS_WAIT() asm volatile("s_waitcnt lgkmcnt(0)" ::: "memory")
#define VM_WAIT() asm volatile("s_waitcnt vmcnt(0)" ::: "memory")
__device__ __forceinline__ unsigned pk2(float lo, float hi) { unsigned r; asm volatile("v_cvt_pk_bf16_f32 %0, %1, %2" : "=v"(r) : "v"(lo), "v"(hi)); return r; }
__device__ __forceinline__ float bflo(unsigned w) { return __uint_as_float(w << 16); }
__device__ __forceinline__ float bfhi(unsigned w) { return __uint_as_float(w & 0xffff0000u); }

#define XB_TMO      128
#define XB_XCNT(j)  (256  + 64 * (j))
#define XB_XSUB(j)  (1280 + 64 * (j))
#define XB_XGEN(j)  (2304 + 64 * (j))
#define XB_TOP      3328
#define XB_TOPGEN   3392
#define XCD_BAR_WORDS 3456
#define XB_SPIN_CAP (1u << 18)
__device__ __forceinline__ unsigned xb_ld(unsigned* p)              { return __hip_atomic_load(p, __ATOMIC_RELAXED, __HIP_MEMORY_SCOPE_AGENT); }
__device__ __forceinline__ unsigned xb_add(unsigned* p, unsigned v) { return __hip_atomic_fetch_add(p, v, __ATOMIC_RELAXED, __HIP_MEMORY_SCOPE_AGENT); }
__device__ __forceinline__ unsigned xb_xcc_id() { return (unsigned)__builtin_amdgcn_s_getreg((3 << 11) | 20) & 0xFu; }
#define XB_SPIN(cond, bar) do { unsigned _sp = 0; while (cond) { __builtin_amdgcn_s_sleep(1); \
    if ((++_sp & 255u) == 0u) { if (xb_ld(&(bar)[XB_TMO])) break; if (_sp > XB_SPIN_CAP) { atomicAdd(&(bar)[XB_TMO], 1u); break; } } } } while (0)
struct XcdBarrier { unsigned* bar; unsigned x; volatile LAS unsigned* st; };
__device__ __forceinline__ XcdBarrier xcd_barrier_post(unsigned* bar, volatile LAS unsigned* st) {
    XcdBarrier b; b.bar = bar; b.x = xb_xcc_id(); b.st = st;
    if (threadIdx.x == 0) (void)xb_add(&bar[XB_XCNT(b.x)], 1u);
    return b;
}
__device__ __forceinline__ void xcd_barrier_complete(unsigned* bar, unsigned x, unsigned& nloc, unsigned& nx) {
    const unsigned G = gridDim.x * gridDim.y * gridDim.z;
    unsigned sum, cnt, mine, sp = 0u;
    for (;;) {
        sum = 0u; cnt = 0u; mine = 0u;
#pragma unroll
        for (unsigned j = 0; j < 16; ++j) { const unsigned c = xb_ld(&bar[XB_XCNT(j)]); sum += c; cnt += (c > 0u) ? 1u : 0u; mine = (j == x) ? c : mine; }
        if (sum == G) break;
        __builtin_amdgcn_s_sleep(1);
        if ((++sp & 255u) == 0u) { if (xb_ld(&bar[XB_TMO])) break; if (sp > XB_SPIN_CAP) { atomicAdd(&bar[XB_TMO], 1u); break; } }
    }
    nloc = mine > 0u ? mine : 1u; nx = cnt > 0u ? cnt : 1u;
}
__device__ __forceinline__ void xcd_barrier(const XcdBarrier& b) {
    asm volatile("s_waitcnt vmcnt(0)" ::: "memory");
    __syncthreads();
    if (threadIdx.x == 0) {
        unsigned* bar = b.bar;
        __builtin_amdgcn_s_waitcnt(0);
        unsigned nloc = b.st[0], nx = b.st[1];
        if (nloc == 0u) { xcd_barrier_complete(bar, b.x, nloc, nx); b.st[0] = nloc; b.st[1] = nx; }
        const unsigned old = xb_add(&bar[XB_XSUB(b.x)], 1u);
        const unsigned gen = old / nloc;
        if (old + 1u == (gen + 1u) * nloc) {
            __builtin_amdgcn_fence(__ATOMIC_RELEASE, "agent");
            asm volatile("s_waitcnt vmcnt(0)" ::: "memory");
            const unsigned og = xb_add(&bar[XB_TOP], 1u);
            const unsigned tg = og / nx;
            if (og + 1u == (tg + 1u) * nx) xb_add(&bar[XB_TOPGEN], 1u);
            else XB_SPIN(xb_ld(&bar[XB_TOPGEN]) == tg, bar);
            __builtin_amdgcn_fence(__ATOMIC_ACQUIRE, "agent");
            xb_add(&bar[XB_XGEN(b.x)], 1u);
            asm volatile("s_waitcnt vmcnt(0)" ::: "memory");
        } else {
            XB_SPIN(xb_ld(&bar[XB_XGEN(b.x)]) == gen, bar);
            __builtin_amdgcn_fence(__ATOMIC_ACQUIRE, "agent");
            asm volatile("s_waitcnt vmcnt(0)" ::: "memory");
        }
    }
    __syncthreads();
}

constexpr size_t MiB = 1u << 20;
constexpr size_t WS_CTL = 0, CTL_ZERO_BYTES = 1 * MiB;
constexpr size_t WS_MOD = 1 * MiB;
constexpr size_t WS_RSTD = 2 * MiB;
constexpr size_t WS_FLOG = 3 * MiB;
constexpr size_t WS_MODP = 4 * MiB;
constexpr size_t WS_WIN = 32 * MiB;
constexpr size_t WS_WOUT = 80 * MiB;
constexpr size_t WS_WPOOL = 96 * MiB;
constexpr size_t WS_WUP = 100 * MiB;
constexpr size_t WS_WDOWN = 276 * MiB;
constexpr size_t WS_H = 364 * MiB;
constexpr size_t WS_Q = 396 * MiB, WS_K = 428 * MiB, WS_V = 460 * MiB;
constexpr size_t WS_AO = 492 * MiB;
constexpr size_t WS_U = 524 * MiB;
constexpr size_t WS_ACT = 700 * MiB;
constexpr size_t WS_END = 788 * MiB;
constexpr int CW_BAR = 4096;
constexpr int CW_QUEUE = 16384;

constexpr int SCR_BYTES = 133120;
constexpr int MISC_OFF = SCR_BYTES;
constexpr int LDS_BYTES = 147456;
constexpr int NWAVES = 8;


struct Args { const float* in[15]; float* out; unsigned char* ws; int ph_lo, ph_hi; };
enum { I_X = 0, I_C, I_WMOD, I_BMOD, I_GAIN, I_WIN, I_BF, I_WOUT, I_WPOOL, I_PSCALE, I_WUP, I_CONVW, I_CONVB, I_WDOWN, I_FGAIN };
__device__ __forceinline__ int opaque_zero() { int z = 0; asm volatile("" : "+s"(z)); return z; }
__device__ __forceinline__ int opaque_v(int v) { asm volatile("" : "+v"(v)); return v; }
__device__ __forceinline__ int opaque_s(int v) { asm volatile("" : "+s"(v)); return v; }
#define ARG_IN(k) (args.in[(k) + zz])
#define ARG_OUT() ((&args.out)[zz])
#define ARG_WS() ((&args.ws)[zz])
#define PHASE_LOCALS const int zz = opaque_zero(); const int tid = opaque_v((int)threadIdx.x), bid = opaque_s((int)blockIdx.x), lane = tid & 63, wave = __builtin_amdgcn_readfirstlane(tid >> 6), G = gridDim.x; unsigned char* const ws = ARG_WS(); (void)lane; (void)wave; (void)G; (void)ws; (void)bid

__device__ __forceinline__ float wave_sum(float v) {
#pragma unroll
    for (int o = 1; o < 64; o <<= 1) v += __shfl_xor(v, o);
    return v;
}
__device__ __forceinline__ float silu_f(float v) { return v / (1.f + __expf(-v)); }

__device__ __forceinline__ void transpose_tile(const float* W, int ldw, int K, bf16* WT, int k0, int n0, LAS float* scr, int lane) {
    const int kq = lane >> 4, nc = (lane & 15) * 4;
    f32x4 v[16];
#pragma unroll
    for (int i = 0; i < 16; ++i) v[i] = *(const GAS f32x4*)(W + (size_t)(k0 + 4 * i + kq) * ldw + n0 + nc);
#pragma unroll
    for (int i = 0; i < 16; ++i) { LAS float* s = scr + (4 * i + kq) * 65 + nc; s[0] = v[i].x; s[1] = v[i].y; s[2] = v[i].z; s[3] = v[i].w; }
    LDS_WAIT(); asm volatile("" ::: "memory");
    const int c = lane & 7, nr = lane >> 3;
#pragma unroll
    for (int j = 0; j < 8; ++j) { const int n = nr + 8 * j; const LAS float* s = scr + (8 * c) * 65 + n;
        v4u o; o.x = pk2(s[0 * 65], s[1 * 65]); o.y = pk2(s[2 * 65], s[3 * 65]); o.z = pk2(s[4 * 65], s[5 * 65]); o.w = pk2(s[6 * 65], s[7 * 65]);
        *(GAS v4u*)(WT + (size_t)(n0 + n) * K + k0 + 8 * c) = o; }
    LDS_WAIT(); asm volatile("" ::: "memory");
}
__device__ __forceinline__ void p0_prologue(const Args& args, LAS unsigned char* lds) {
    PHASE_LOCALS;
    LAS float* scr = (LAS float*)(lds + wave * 16640);
    const int gw = bid * NWAVES + wave, NGW = G * NWAVES;
    constexpr int MOD_ITEMS = DEPTH * 32 * (NMOD / 256);
    float* modp = (float*)(ws + WS_MODP);
    { const float* c_in = ARG_IN(I_C); const float* w_mod = ARG_IN(I_WMOD);
    for (int it = gw; it < MOD_ITEMS; it += NGW) {
        const int l = it / (32 * 48), rem = it % (32 * 48), kc = rem / 48, nb = rem % 48;
        const int k0 = kc * 64, n = nb * 256 + lane * 4;
        { f32x4 cb;
          cb.x = silu_f(c_in[0 * DM + k0 + lane]); cb.y = silu_f(c_in[1 * DM + k0 + lane]); cb.z = silu_f(c_in[2 * DM + k0 + lane]); cb.w = silu_f(c_in[3 * DM + k0 + lane]);
          *(LAS f32x4*)(scr + 4 * lane) = cb; }
        LDS_WAIT(); asm volatile("" ::: "memory");
        f32x4 acc[4] = {};
        const float* wp = w_mod + ((size_t)l * DM + k0) * NMOD + n;
#pragma unroll 16
        for (int kk = 0; kk < 64; ++kk) {
            const f32x4 w = *(const GAS f32x4*)(wp + (size_t)kk * NMOD);
            const f32x4 s = *(const LAS f32x4*)(scr + 4 * kk);
            acc[0] = acc[0] + w * s.x; acc[1] = acc[1] + w * s.y; acc[2] = acc[2] + w * s.z; acc[3] = acc[3] + w * s.w;
        }
        LDS_WAIT(); asm volatile("" ::: "memory");
#pragma unroll
        for (int b = 0; b < 4; ++b) *(GAS f32x4*)(modp + (((size_t)kc * DEPTH + l) * BATCH + b) * NMOD + n) = acc[b];
    } }
    constexpr int T_IN = (DM / 64) * (NQKV / 64), T_OUT = (DM / 64) * (DM / 64), T_POOL = 8 * 8, T_UP = (DM / 64) * (F2 / 64), T_DOWN = (DFF / 64) * (DM / 64);
    constexpr int E0 = 2 * T_IN, E1 = E0 + 2 * T_OUT, E2 = E1 + 8 * T_POOL, E3 = E2 + 4 * T_UP, T_ALL = E3 + 4 * T_DOWN;
    for (int it = gw; it < T_ALL; it += NGW) {
        const float* W; bf16* WT; int ldw, K, N, r;
        if (it < E0)      { const int i = it / T_IN;  r = it % T_IN;  W = ARG_IN(I_WIN) + (size_t)i * DM * NIN;  ldw = NIN; K = DM;  N = NQKV; WT = (bf16*)(ws + WS_WIN) + (size_t)i * NQKV * DM; }
        else if (it < E1) { const int q = it - E0, i = q / T_OUT;  r = q % T_OUT;  W = ARG_IN(I_WOUT) + (size_t)i * DM * DM;  ldw = DM;  K = DM;  N = DM;   WT = (bf16*)(ws + WS_WOUT) + (size_t)i * DM * DM; }
        else if (it < E2) { const int q = it - E1, i = q / T_POOL; r = q % T_POOL; W = ARG_IN(I_WPOOL) + (size_t)i * 512 * 512; ldw = 512; K = 512; N = 512;  WT = (bf16*)(ws + WS_WPOOL) + (size_t)i * 512 * 512; }
        else if (it < E3) { const int q = it - E2, i = q / T_UP;   r = q % T_UP;   W = ARG_IN(I_WUP) + (size_t)i * DM * F2;    ldw = F2;  K = DM;  N = F2;   WT = (bf16*)(ws + WS_WUP) + (size_t)i * F2 * DM; }
        else              { const int q = it - E3, i = q / T_DOWN; r = q % T_DOWN; W = ARG_IN(I_WDOWN) + (size_t)i * DFF * DM; ldw = DM;  K = DFF; N = DM;   WT = (bf16*)(ws + WS_WDOWN) + (size_t)i * DM * DFF; }
        const int nb = N / 64;
        transpose_tile(W, ldw, K, WT, (r / nb) * 64, (r % nb) * 64, scr, lane);
    }
}
__device__ __forceinline__ void p0b_modreduce(const Args& args) {
    PHASE_LOCALS;
    const float* modp = (const float*)(ws + WS_MODP); float* mod = (float*)(ws + WS_MOD); const float* b_mod = ARG_IN(I_BMOD);
    constexpr int TOT4 = DEPTH * BATCH * NMOD / 4;
    for (int i = bid * 512 + tid; i < TOT4; i += G * 512) {
        const int e = i * 4, l = e / (BATCH * NMOD), n = e % NMOD;
        f32x4 s = *(const GAS f32x4*)(b_mod + (size_t)l * NMOD + n);
#pragma unroll 8
        for (int kc = 0; kc < 32; ++kc) s = s + *(const GAS f32x4*)(modp + (size_t)kc * (DEPTH * BATCH * NMOD) + e);
        *(GAS f32x4*)(mod + e) = s;
    }
}

template <int MODE>
__device__ __forceinline__ void norm_phase(const Args& args, LAS unsigned char* lds, int l) {
    PHASE_LOCALS;
    const int li = l >> 1;
    const float* x = (l == 0 && MODE < 2) ? ARG_IN(I_X) : (const float*)ARG_OUT();
    const float* gain = (MODE == 3) ? ARG_IN(I_FGAIN) : ARG_IN(I_GAIN) + (size_t)(l * 2 + (MODE == 2 ? 1 : 0)) * DM;
    const float* modl = (const float*)(ws + WS_MOD) + (size_t)l * BATCH * NMOD;
    const int shift_off = (MODE == 2) ? 3 * DM : 0;
    LAS float* wg = (LAS float*)lds;
    if (MODE == 0) {
        const float* wgate = ARG_IN(I_WIN) + (size_t)li * DM * NIN;
        __syncthreads();
        for (int i = tid; i < DM * NFX; i += 512) { const int k = i >> 3, j = i & 7; wg[j * DM + k] = wgate[(size_t)k * NIN + NQKV + j]; }
        __syncthreads();
    }
    const int gw = bid * NWAVES + wave, NGW = G * NWAVES;
    bf16* Hb = (bf16*)(ws + WS_H); float* rstd_o = (float*)(ws + WS_RSTD); float* flog = (float*)(ws + WS_FLOG);
    for (int rb = gw; rb < M / 4; rb += NGW) {
        const int m0 = rb * 4, b = m0 / SEQ;
        f32x4 gv[8], sh[8];
        if (MODE != 1) {
#pragma unroll
            for (int j = 0; j < 8; ++j) { const int cidx = (lane + 64 * j) * 4;
                gv[j] = *(const GAS f32x4*)(gain + cidx);
                if (MODE != 3) { const f32x4 sc = *(const GAS f32x4*)(modl + (size_t)b * NMOD + shift_off + DM + cidx); gv[j] = gv[j] * (sc + 1.0f);
                                 sh[j] = *(const GAS f32x4*)(modl + (size_t)b * NMOD + shift_off + cidx); } }
        }
        for (int rr = 0; rr < 4; ++rr) {
            const int m = m0 + rr;
            const GAS f32x4* xr = (const GAS f32x4*)(x + (size_t)m * DM) + lane;
            f32x4 v[8]; float ss = 0.f;
#pragma unroll
            for (int j = 0; j < 8; ++j) { v[j] = xr[64 * j]; ss += (v[j].x * v[j].x + v[j].y * v[j].y) + (v[j].z * v[j].z + v[j].w * v[j].w); }
            const float rstd = 1.0f / sqrtf(wave_sum(ss) * (1.0f / DM) + EPS);
            if (MODE == 1) { if (lane == 0) rstd_o[m] = rstd; continue; }
            if (MODE == 3) {
                GAS f32x4* o = (GAS f32x4*)(ARG_OUT() + (size_t)m * DM) + lane;
#pragma unroll
                for (int j = 0; j < 8; ++j) o[64 * j] = v[j] * rstd * gv[j];
                continue;
            }
#pragma unroll
            for (int j = 0; j < 8; ++j) v[j] = v[j] * rstd * gv[j] + sh[j];
            GAS v2u* o8 = (GAS v2u*)(Hb + (size_t)m * DM) + lane;
#pragma unroll
            for (int j = 0; j < 8; ++j) { v2u w; w.x = pk2(v[j].x, v[j].y); w.y = pk2(v[j].z, v[j].w); o8[64 * j] = w; }
            if (MODE == 0) {
                float g8[8];
#pragma unroll
                for (int q = 0; q < 8; ++q) { float a = 0.f;
#pragma unroll
                    for (int j = 0; j < 8; ++j) { const f32x4 w = *(const LAS f32x4*)(wg + q * DM + (lane + 64 * j) * 4); a += (v[j].x * w.x + v[j].y * w.y) + (v[j].z * w.z + v[j].w * w.w); }
                    g8[q] = wave_sum(a); }
                if (lane < 8) { float f = 0.f;
#pragma unroll
                    for (int q = 0; q < 8; ++q) f = (lane == q) ? g8[q] : f;
                    f += ARG_IN(I_BF)[li * NFX + lane];
                    const float ls = fminf(f, 0.f) - log1pf(expf(-fabsf(f)));
                    flog[((size_t)b * NFX + lane) * SEQ + (m - b * SEQ)] = ls; }
            }
        }
    }
}

__device__ __forceinline__ void pooldiff_phase(const Args& args, int l) {
    PHASE_LOCALS;
    const float* x = (const float*)ARG_OUT();
    const float* gain = ARG_IN(I_GAIN) + (size_t)(l * 2) * DM;
    const float* modl = (const float*)(ws + WS_MOD) + (size_t)l * BATCH * NMOD;
    const int gw = bid * NWAVES + wave, NGW = G * NWAVES;
    const float* rstd = (const float*)(ws + WS_RSTD); bf16* Hb = (bf16*)(ws + WS_H);
    for (int it = gw; it < (M / 16) * 4; it += NGW) {
        const int grp = it & 3, chunk = it >> 2, t0 = chunk * 16, b = t0 / SEQ, tp0 = t0 - b * SEQ;
        const int w = 2 << grp;
        const int col = grp * 512 + lane * 8;
        f32x4 g0 = *(const GAS f32x4*)(gain + col), g1 = *(const GAS f32x4*)(gain + col + 4);
        g0 = g0 * (*(const GAS f32x4*)(modl + (size_t)b * NMOD + DM + col) + 1.0f); g1 = g1 * (*(const GAS f32x4*)(modl + (size_t)b * NMOD + DM + col + 4) + 1.0f);
        f32x4 s0 = {0.f, 0.f, 0.f, 0.f}, s1 = {0.f, 0.f, 0.f, 0.f};
        int tstart = tp0 - w; if (tstart < 0) tstart = 0;
        for (int tp = tstart; tp < tp0; ++tp) { const size_t m = (size_t)b * SEQ + tp; const float r = rstd[m];
            s0 = s0 + *(const GAS f32x4*)(x + m * DM + col) * r; s1 = s1 + *(const GAS f32x4*)(x + m * DM + col + 4) * r; }
        for (int i = 0; i < 16; ++i) { const int tp = tp0 + i; const size_t m = (size_t)b * SEQ + tp; const float r = rstd[m];
            const f32x4 y0 = *(const GAS f32x4*)(x + m * DM + col) * r, y1 = *(const GAS f32x4*)(x + m * DM + col + 4) * r;
            s0 = s0 + y0; s1 = s1 + y1;
            if (tp >= w) { const size_t mo = m - w; const float ro = rstd[mo];
                s0 = s0 - *(const GAS f32x4*)(x + mo * DM + col) * ro; s1 = s1 - *(const GAS f32x4*)(x + mo * DM + col + 4) * ro; }
            const float inv = 1.0f / (float)((tp + 1 < w) ? (tp + 1) : w);
            const f32x4 d0 = (s0 * inv - y0) * g0, d1 = (s1 * inv - y1) * g1;
            v4u o; o.x = pk2(d0.x, d0.y); o.y = pk2(d0.z, d0.w); o.z = pk2(d1.x, d1.y); o.w = pk2(d1.z, d1.w);
            *(GAS v4u*)(Hb + m * DM + col) = o; }
    }
}

__device__ __forceinline__ void convgate_phase(const Args& args, int l) {
    PHASE_LOCALS;
    const float* cw = ARG_IN(I_CONVW) + (size_t)l * 3 * F2; const float* cb = ARG_IN(I_CONVB) + (size_t)l * F2;
    const int gw = bid * NWAVES + wave, NGW = G * NWAVES;
    const bf16* U = (const bf16*)(ws + WS_U); bf16* A = (bf16*)(ws + WS_ACT);
    constexpr int NCB = DFF / 512;
    for (int it = gw; it < (M / 16) * NCB; it += NGW) {
        const int cbk = it % NCB, chunk = it / NCB, t0 = chunk * 16, tp0 = t0 % SEQ;
        const int col = cbk * 512 + lane * 8;
        float wa[3][8], wgt[3][8], ba[8], bg[8];
#pragma unroll
        for (int i = 0; i < 3; ++i) {
            const f32x4 a0 = *(const GAS f32x4*)(cw + (size_t)i * F2 + col), a1 = *(const GAS f32x4*)(cw + (size_t)i * F2 + col + 4);
            const f32x4 b0 = *(const GAS f32x4*)(cw + (size_t)i * F2 + DFF + col), b1 = *(const GAS f32x4*)(cw + (size_t)i * F2 + DFF + col + 4);
            wa[i][0] = a0.x; wa[i][1] = a0.y; wa[i][2] = a0.z; wa[i][3] = a0.w; wa[i][4] = a1.x; wa[i][5] = a1.y; wa[i][6] = a1.z; wa[i][7] = a1.w;
            wgt[i][0] = b0.x; wgt[i][1] = b0.y; wgt[i][2] = b0.z; wgt[i][3] = b0.w; wgt[i][4] = b1.x; wgt[i][5] = b1.y; wgt[i][6] = b1.z; wgt[i][7] = b1.w; }
        { const f32x4 a0 = *(const GAS f32x4*)(cb + col), a1 = *(const GAS f32x4*)(cb + col + 4), b0 = *(const GAS f32x4*)(cb + DFF + col), b1 = *(const GAS f32x4*)(cb + DFF + col + 4);
          ba[0] = a0.x; ba[1] = a0.y; ba[2] = a0.z; ba[3] = a0.w; ba[4] = a1.x; ba[5] = a1.y; ba[6] = a1.z; ba[7] = a1.w;
          bg[0] = b0.x; bg[1] = b0.y; bg[2] = b0.z; bg[3] = b0.w; bg[4] = b1.x; bg[5] = b1.y; bg[6] = b1.z; bg[7] = b1.w; }
        v4u pa2 = {0u, 0u, 0u, 0u}, pa1 = {0u, 0u, 0u, 0u}, pg2 = {0u, 0u, 0u, 0u}, pg1 = {0u, 0u, 0u, 0u};
        if (tp0 >= 2) { const bf16* r2 = U + (size_t)(t0 - 2) * F2 + col; const bf16* r1 = U + (size_t)(t0 - 1) * F2 + col;
            pa2 = *(const GAS v4u*)r2; pg2 = *(const GAS v4u*)(r2 + DFF); pa1 = *(const GAS v4u*)r1; pg1 = *(const GAS v4u*)(r1 + DFF); }
#pragma unroll 4
        for (int i = 0; i < 16; ++i) {
            const bf16* r0 = U + (size_t)(t0 + i) * F2 + col;
            const v4u ca = *(const GAS v4u*)r0, cg = *(const GAS v4u*)(r0 + DFF);
            unsigned ow[4];
#pragma unroll
            for (int q = 0; q < 4; ++q) {
                const float ya0 = ba[2 * q] + wa[0][2 * q] * bflo(pa2[q]) + wa[1][2 * q] * bflo(pa1[q]) + wa[2][2 * q] * bflo(ca[q]);
                const float ya1 = ba[2 * q + 1] + wa[0][2 * q + 1] * bfhi(pa2[q]) + wa[1][2 * q + 1] * bfhi(pa1[q]) + wa[2][2 * q + 1] * bfhi(ca[q]);
                const float yg0 = bg[2 * q] + wgt[0][2 * q] * bflo(pg2[q]) + wgt[1][2 * q] * bflo(pg1[q]) + wgt[2][2 * q] * bflo(cg[q]);
                const float yg1 = bg[2 * q + 1] + wgt[0][2 * q + 1] * bfhi(pg2[q]) + wgt[1][2 * q + 1] * bfhi(pg1[q]) + wgt[2][2 * q + 1] * bfhi(cg[q]);
                ow[q] = pk2(silu_f(yg0) * ya0, silu_f(yg1) * ya1); }
            v4u o; o.x = ow[0]; o.y = ow[1]; o.z = ow[2]; o.w = ow[3];
            *(GAS v4u*)(A + (size_t)(t0 + i) * DFF + col) = o;
            pa2 = pa1; pa1 = ca; pg2 = pg1; pg1 = cg;
        }
    }
}

namespace att {
constexpr int KVBLK = 64, QBLK = 32, QB = 256, SHM_V = KVBLK * HD * 2, SHM_K = KVBLK * HD * 2;
constexpr int OFF_V = 0, OFF_K = 2 * SHM_V, OFF_FS = 65536, OFF_WS = OFF_FS + 8192, OFF_FLAGS = OFF_WS + 2048, OFF_SCAN = OFF_FLAGS + 64, ATT_LDS = OFF_SCAN + 64;
#define KSWZ(row, colB) ((row) * 256 + ((colB) ^ (((row) & 7) << 4)))
#define SBAR() __builtin_amdgcn_sched_barrier(0)
__device__ __forceinline__ int v_st(int k, int c) { const int kk = (k & ~0xC) | ((k & 4) << 1) | ((k & 8) >> 1); return ((kk >> 3) * 4 + (c >> 5)) * 512 + ((kk & 7) * 32 + (c & 31)) * 2; }
__device__ __forceinline__ int v_rd_base(int lane) { return ((lane & 3) << 3) | (((lane >> 2) & 3) << 6) | (((lane >> 4) & 1) << 5) | (((lane >> 5) & 1) << 8); }
constexpr int v_rd_off(int d0, int ks, int half) { return d0 * 512 + ks * 4096 + half * 2048; }
__device__ __forceinline__ int crow(int r, int hi) { return (r & 3) + 8 * (r >> 2) + 4 * hi; }
__device__ __forceinline__ unsigned cvtpk(float lo, float hi) { unsigned r; asm volatile("v_cvt_pk_bf16_f32 %0, %1, %2" : "=v"(r) : "v"(lo), "v"(hi)); return r; }

__device__ __forceinline__ void qkt(f32x16& p0, f32x16& p1, const LAS unsigned char* kbase, int r32, int hi, const bf16x8* qr) {
    p0 = f32x16{}; p1 = f32x16{};
    const LAS unsigned char* kb[4];
#pragma unroll
    for (int dd = 0; dd < 4; ++dd) kb[dd] = kbase + KSWZ(r32, (dd * 16 + hi * 8) * 2);
#pragma unroll
    for (int d0 = 0; d0 < 8; ++d0) { const LAS unsigned char* a = kb[d0 & 3] + (d0 >> 2) * 128;
        const bf16x8 b0 = *(const LAS bf16x8*)a;
        const bf16x8 b1 = *(const LAS bf16x8*)(a + 32 * 256);
        p0 = __builtin_amdgcn_mfma_f32_32x32x16_bf16(b0, qr[d0], p0, 0, 0, 0);
        p1 = __builtin_amdgcn_mfma_f32_32x32x16_bf16(b1, qr[d0], p1, 0, 0, 0); }
}
__device__ __forceinline__ void pv_tile(f32x16* o, unsigned vb0, bf16x8 pa0, bf16x8 pa1, bf16x8 pa2, bf16x8 pa3) {
#define TRRD(dst, off) asm volatile("ds_read_b64_tr_b16 %0, %1 offset:%2" : "=&v"(dst) : "v"(vb0), "i"(off) : "memory")
#define PV_D0(d0) do { s16x4 l0, l1, l2, l3, h0, h1, h2, h3; constexpr int b_ = v_rd_off(d0, 0, 0); \
        TRRD(l0, b_); TRRD(h0, b_ + 2048); TRRD(l1, b_ + 4096); TRRD(h1, b_ + 6144); TRRD(l2, b_ + 8192); TRRD(h2, b_ + 10240); TRRD(l3, b_ + 12288); TRRD(h3, b_ + 14336); \
        asm volatile("s_waitcnt lgkmcnt(0)" ::: "memory"); SBAR(); \
        o[d0] = __builtin_amdgcn_mfma_f32_32x32x16_bf16(pa0, (bf16x8){l0[0], l0[1], l0[2], l0[3], h0[0], h0[1], h0[2], h0[3]}, o[d0], 0, 0, 0); \
        o[d0] = __builtin_amdgcn_mfma_f32_32x32x16_bf16(pa1, (bf16x8){l1[0], l1[1], l1[2], l1[3], h1[0], h1[1], h1[2], h1[3]}, o[d0], 0, 0, 0); \
        o[d0] = __builtin_amdgcn_mfma_f32_32x32x16_bf16(pa2, (bf16x8){l2[0], l2[1], l2[2], l2[3], h2[0], h2[1], h2[2], h2[3]}, o[d0], 0, 0, 0); \
        o[d0] = __builtin_amdgcn_mfma_f32_32x32x16_bf16(pa3, (bf16x8){l3[0], l3[1], l3[2], l3[3], h3[0], h3[1], h3[2], h3[3]}, o[d0], 0, 0, 0); } while (0)
    PV_D0(0); PV_D0(1); PV_D0(2); PV_D0(3);
#undef PV_D0
#undef TRRD
}
#define PK4(P, B_, OUT) do { unsigned a0 = cvtpk(P[B_+0], P[B_+1]), a1 = cvtpk(P[B_+2], P[B_+3]); \
        unsigned b0 = cvtpk(P[B_+4], P[B_+5]), b1 = cvtpk(P[B_+6], P[B_+7]); \
        auto r0 = __builtin_amdgcn_permlane32_swap(a0, b0, false, false); auto r1 = __builtin_amdgcn_permlane32_swap(a1, b1, false, false); \
        v4u w = {r0[0], r1[0], r0[1], r1[1]}; OUT = __builtin_bit_cast(bf16x8, w); } while (0)

template <bool FOX>
__device__ __forceinline__ void unit(LAS unsigned char* lds, const bf16* Q, const bf16* K, const bf16* V, bf16* O, const float* flog_bh, int b, int h, int qb, const int tid) {
    const int wid = __builtin_amdgcn_readfirstlane(tid >> 6), lane = tid & 63, r32 = lane & 31, hi = lane >> 5;
    const size_t rowbase = (size_t)b * SEQ;
    const int P0 = qb * QB, qlo = P0 + wid * QBLK, tpos = qlo + r32;
    LAS float* Fs = (LAS float*)(lds + OFF_FS);
    LAS float* wsf = (LAS float*)(lds + OFF_WS) + wid * 64; LAS float* li_l = wsf; LAS float* al_l = wsf + 32;
    volatile LAS int* flags = (volatile LAS int*)(lds + OFF_FLAGS);
    LAS float* scanp = (LAS float*)(lds + OFF_SCAN);
    const unsigned ldsb = (unsigned)(uintptr_t)lds;
    __syncthreads();
    if (FOX) {
        f32x4 v = *(const GAS f32x4*)(flog_bh + 4 * tid);
        v.y += v.x; v.z += v.y; v.w += v.z;
        float inc = v.w;
#pragma unroll
        for (int o = 1; o < 64; o <<= 1) { const float t = __shfl_up(inc, o); if (lane >= o) inc += t; }
        if (lane == 63) scanp[wid] = inc;
        __syncthreads();
        float off = inc - v.w;
#pragma unroll
        for (int w = 0; w < 8; ++w) off += (w < wid) ? scanp[w] : 0.f;
        *(LAS f32x4*)(Fs + 4 * tid) = (v + off) * LOG2E;
    }
    bf16x8 qr[8];
    { const bf16* qp = Q + (rowbase + tpos) * DM + h * HD + hi * 8;
#pragma unroll
      for (int d0 = 0; d0 < 8; ++d0) qr[d0] = *(const GAS bf16x8*)(qp + d0 * 16); }
    const int sr = tid >> 4, sc = (tid & 15) * 8;
    const unsigned vst0 = v_st(sr, sc), vst1 = v_st(32 + sr, sc), kws = KSWZ(sr, sc * 2);
    const bf16* Kh = K + rowbase * DM + h * HD + sc; const bf16* Vh = V + rowbase * DM + h * HD + sc;
    const unsigned vrd = ldsb + OFF_V + v_rd_base(lane);
    bf16x8 st_k0, st_k1, st_v0, st_v1;
#define SLOAD(k0) do { st_k0 = *(const GAS bf16x8*)(Kh + (size_t)((k0) + sr) * DM); st_k1 = *(const GAS bf16x8*)(Kh + (size_t)((k0) + 32 + sr) * DM); \
                       st_v0 = *(const GAS bf16x8*)(Vh + (size_t)((k0) + sr) * DM); st_v1 = *(const GAS bf16x8*)(Vh + (size_t)((k0) + 32 + sr) * DM); } while (0)
#define SWRITE(bf) do { *(LAS bf16x8*)(lds + OFF_K + (bf) * SHM_K + kws) = st_k0; *(LAS bf16x8*)(lds + OFF_K + (bf) * SHM_K + kws + 32 * 256) = st_k1; \
                        *(LAS bf16x8*)(lds + OFF_V + (bf) * SHM_V + vst0) = st_v0; *(LAS bf16x8*)(lds + OFF_V + (bf) * SHM_V + vst1) = st_v1; } while (0)
    int jt = (P0 + QB - 1) / KVBLK;
    SLOAD(jt * KVBLK); VM_WAIT(); SWRITE(0);
    __syncthreads();
    f32x16 o[4] = {};
    float m_reg = -1e30f, l_reg = 0.f, R = 1.0f;
    const float Ft2 = FOX ? Fs[tpos] : 0.f;
    constexpr float C2 = LOG2E * ATT_SCALE;
    int buf = 0, it = 0; bool wdone = false;
    for (;;) {
        const int kb = jt * KVBLK;
        const bool more = jt > 0;
        if (more) SLOAD(kb - KVBLK);
        const bool act = FOX ? (kb <= qlo + QBLK - 1) : (kb <= qlo + QBLK - 2 && !wdone);
        if (act) {
            f32x16 p0, p1;
            qkt(p0, p1, lds + OFF_K + buf * SHM_K, r32, hi, qr);
            bf16x8 pa0, pa1, pa2, pa3;
            if (FOX) {
#pragma unroll
                for (int g = 0; g < 4; ++g) { const f32x4 f0 = *(const LAS f32x4*)(Fs + kb + 8 * g + 4 * hi), f1 = *(const LAS f32x4*)(Fs + kb + 32 + 8 * g + 4 * hi);
#pragma unroll
                    for (int e = 0; e < 4; ++e) { p0[4 * g + e] = fmaf(p0[4 * g + e], C2, Ft2 - f0[e]); p1[4 * g + e] = fmaf(p1[4 * g + e], C2, Ft2 - f1[e]); } }
                if (kb + KVBLK - 1 > qlo) {
                    const float NEG = -__builtin_inff(); const int dq = tpos - kb - 4 * hi;
#pragma unroll
                    for (int r = 0; r < 16; ++r) { const int c = (r & 3) + 8 * (r >> 2); if (c > dq) p0[r] = NEG; if (c + 32 > dq) p1[r] = NEG; }
                }
                float pmax = p0[0];
#pragma unroll
                for (int r = 1; r < 16; ++r) pmax = fmaxf(pmax, p0[r]);
#pragma unroll
                for (int r = 0; r < 16; ++r) pmax = fmaxf(pmax, p1[r]);
                { auto rr = __builtin_amdgcn_permlane32_swap(__float_as_uint(pmax), __float_as_uint(pmax), false, false); pmax = fmaxf(__uint_as_float(rr[0]), __uint_as_float(rr[1])); }
                const float mn = fmaxf(m_reg, pmax); const float alpha = __builtin_amdgcn_exp2f(m_reg - mn); m_reg = mn;
                float ps = 0.f;
#pragma unroll
                for (int r = 0; r < 16; ++r) { p0[r] = __builtin_amdgcn_exp2f(p0[r] - mn); p1[r] = __builtin_amdgcn_exp2f(p1[r] - mn); ps += p0[r] + p1[r]; }
                { auto rr = __builtin_amdgcn_permlane32_swap(__float_as_uint(ps), __float_as_uint(ps), false, false); ps = __uint_as_float(rr[0]) + __uint_as_float(rr[1]); }
                l_reg = l_reg * alpha + ps;
                if (__any(alpha < 1.f)) { if (hi == 0) al_l[r32] = alpha; LDS_WAIT();
#pragma unroll
                    for (int r = 0; r < 16; ++r) { const float a = al_l[crow(r, hi)];
#pragma unroll
                        for (int d_ = 0; d_ < 4; ++d_) o[d_][r] *= a; } }
            } else {
                const int dq = tpos - kb - 4 * hi;
                const bool needmask = (kb + KVBLK - 1 >= qlo);
#pragma unroll
                for (int r = 0; r < 16; ++r) { const int c = (r & 3) + 8 * (r >> 2);
                    const float u0 = __builtin_amdgcn_exp2f(fminf(p0[r] * C2, 115.f)), u1 = __builtin_amdgcn_exp2f(fminf(p1[r] * C2, 115.f));
                    float r0 = __builtin_amdgcn_rcpf(1.0f + u0), r1 = __builtin_amdgcn_rcpf(1.0f + u1);
                    if (needmask) { if (c >= dq) r0 = 1.0f; if (c + 32 >= dq) r1 = 1.0f; }
                    p0[r] = r0; p1[r] = r1; }
                float og[8], pg[8];
#pragma unroll
                for (int i = 0; i < 4; ++i) { og[i] = (p0[4 * i] * p0[4 * i + 1]) * (p0[4 * i + 2] * p0[4 * i + 3]); og[4 + i] = (p1[4 * i] * p1[4 * i + 1]) * (p1[4 * i + 2] * p1[4 * i + 3]); }
#pragma unroll
                for (int i = 0; i < 8; ++i) { auto rr = __builtin_amdgcn_permlane32_swap(__float_as_uint(og[i]), __float_as_uint(og[i]), false, false);
                    pg[i] = hi ? __uint_as_float(rr[0]) : __uint_as_float(rr[1]); }
                float Srun = R;
#pragma unroll
                for (int j = 7; j >= 0; --j) {
                    const float ex = hi ? Srun : Srun * pg[j];
                    Srun = Srun * og[j] * pg[j];
                    if (j >= 4) { const int i = j - 4; const float e3 = ex, e2 = e3 * p1[4 * i + 3], e1 = e2 * p1[4 * i + 2], e0 = e1 * p1[4 * i + 1];
                        p1[4 * i] = (1.0f - p1[4 * i]) * e0; p1[4 * i + 1] = (1.0f - p1[4 * i + 1]) * e1; p1[4 * i + 2] = (1.0f - p1[4 * i + 2]) * e2; p1[4 * i + 3] = (1.0f - p1[4 * i + 3]) * e3; }
                    else { const int i = j; const float e3 = ex, e2 = e3 * p0[4 * i + 3], e1 = e2 * p0[4 * i + 2], e0 = e1 * p0[4 * i + 1];
                        p0[4 * i] = (1.0f - p0[4 * i]) * e0; p0[4 * i + 1] = (1.0f - p0[4 * i + 1]) * e1; p0[4 * i + 2] = (1.0f - p0[4 * i + 2]) * e2; p0[4 * i + 3] = (1.0f - p0[4 * i + 3]) * e3; }
                }
                R = Srun;
                wdone = __all(R < SB_EXIT);
            }
            PK4(p0, 0, pa0); PK4(p0, 8, pa1); PK4(p1, 0, pa2); PK4(p1, 8, pa3);
            pv_tile(o, vrd + buf * SHM_V, pa0, pa1, pa2, pa3);
        }
        if (!FOX) { if (lane == 0) flags[(it & 1) * 8 + wid] = wdone ? 1 : 0; }
        if (more) { VM_WAIT(); SWRITE(buf ^ 1); }
        __syncthreads();
        if (!more) break;
        if (!FOX) { int alld = 1;
#pragma unroll
            for (int w = 0; w < 8; ++w) alld &= flags[(it & 1) * 8 + w];
            if (alld) break; }
        buf ^= 1; --jt; ++it;
    }
#undef SLOAD
#undef SWRITE
    float rli[16];
    if (FOX) { if (hi == 0) li_l[r32] = l_reg; LDS_WAIT();
#pragma unroll
        for (int r = 0; r < 16; ++r) rli[r] = __builtin_amdgcn_rcpf(li_l[crow(r, hi)]); }
    bf16* Ow = O + (rowbase + qlo) * DM + h * HD;
#pragma unroll
    for (int r = 0; r < 16; ++r) { const int orow = crow(r, hi);
#pragma unroll
        for (int d0 = 0; d0 < 4; ++d0) { const float v = FOX ? o[d0][r] * rli[r] : o[d0][r];
            const float vn = __shfl_xor(v, 1);
            if ((r32 & 1) == 0) *(GAS unsigned*)(Ow + (size_t)orow * DM + d0 * 32 + r32) = cvtpk(v, vn); } }
}
#undef PK4
}

__device__ __forceinline__ void attention_phase(const Args& args, LAS unsigned char* lds, int li) {
    PHASE_LOCALS;
    volatile LAS unsigned* MISC = (volatile LAS unsigned*)(lds + MISC_OFF);
    const bf16* Q = (const bf16*)(ws + WS_Q); const bf16* K = (const bf16*)(ws + WS_K); const bf16* V = (const bf16*)(ws + WS_V); bf16* O = (bf16*)(ws + WS_AO);
    const float* flog = (const float*)(ws + WS_FLOG);
    gu32* head = (gu32*)(ws + WS_CTL) + CW_QUEUE + 64 * li;
    for (;;) {
        __syncthreads();
        if (tid == 0) MISC[16] = __hip_atomic_fetch_add(head, 1u, RLX_AGENT);
        __syncthreads();
        const int item = (int)MISC[16];
        if (item >= 512) break;
        const int fox = item < 256 ? 1 : 0, r = item & 255, qb = 7 - (r >> 5), bh = r & 31, b = bh >> 3, h = (bh & 7) + (fox ? NSB : 0);
        if (fox) att::unit<true>(lds, Q, K, V, O, flog + ((size_t)b * NFX + (h - NSB)) * SEQ, b, h, qb, tid);
        else att::unit<false>(lds, Q, K, V, O, flog, b, h, qb, tid);
    }
}

template <int KIND>
__device__ __forceinline__ void gemm_bf16_phase(const Args& args, LAS unsigned char* lds, int l) {
    PHASE_LOCALS;
    const bf16* Hb = (const bf16*)(ws + WS_H);
    if (KIND == 0) {
        pg8::Gemm g{Hb, (const bf16*)(ws + WS_WIN) + (size_t)(l >> 1) * NQKV * DM, M, NQKV, DM, DM, 0};
        pg8::StaticOrder S; S.init(M, NQKV, G, bid);
        pg8::EpiBf16 E{(bf16*)(ws + WS_Q), DM, DM, (size_t)M * DM};
        pg8::gemm_phase<pg8::EpiBf16, pg8::StaticOrder, true, true>(lds, g, S, E, tid);
    } else {
        pg8::Gemm g{Hb, (const bf16*)(ws + WS_WUP) + (size_t)l * F2 * DM, M, F2, DM, DM, 0};
        pg8::StaticOrder S; S.init(M, F2, G, bid);
        pg8::EpiBf16 E{(bf16*)(ws + WS_U), F2, 0, 0};
        pg8::gemm_phase<pg8::EpiBf16, pg8::StaticOrder, true, true>(lds, g, S, E, tid);
    }
}
__device__ __forceinline__ void gemm_resid_phase(const Args& args, LAS unsigned char* lds, int l, int kind) {
    PHASE_LOCALS;
    const int li = l >> 1;
    const float* modl = (const float*)(ws + WS_MOD) + (size_t)l * BATCH * NMOD;
    float* out = ARG_OUT();
    pg8::Gemm g; pg8::EpiResid E{out, out, modl + (kind == 2 ? 5 * DM : 2 * DM), nullptr};
    if (kind == 0) { g = pg8::Gemm{(const bf16*)(ws + WS_AO), (const bf16*)(ws + WS_WOUT) + (size_t)li * DM * DM, M, DM, DM, DM, 0}; if (l == 0) E.xin = ARG_IN(I_X); }
    else if (kind == 1) { g = pg8::Gemm{(const bf16*)(ws + WS_H), (const bf16*)(ws + WS_WPOOL) + (size_t)li * 4 * 512 * 512, M, DM, 512, DM, 1}; E.pscale = ARG_IN(I_PSCALE) + (size_t)li * DM; }
    else g = pg8::Gemm{(const bf16*)(ws + WS_ACT), (const bf16*)(ws + WS_WDOWN) + (size_t)l * DM * DFF, M, DM, DFF, DFF, 0};
    pg8::StaticOrder S; S.init(M, DM, G, bid);
    pg8::gemm_phase<pg8::EpiResid, pg8::StaticOrder, false, true>(lds, g, S, E, tid);
}

#ifndef EN_MASK
#define EN_MASK 0xffff
#endif
#define EN(b) ((EN_MASK >> (b)) & 1)
constexpr int NPHASES = 2 + DEPTH * 8 + 1;
__global__ void __launch_bounds__(NWAVES * 64, 2) fwd_kernel(Args args) {
    extern __shared__ __attribute__((aligned(16))) unsigned char lds_raw[];
    LAS unsigned char* lds = (LAS unsigned char*)lds_raw;
    volatile LAS unsigned* MISC = (volatile LAS unsigned*)(lds + MISC_OFF);
    if (threadIdx.x < 32) MISC[threadIdx.x] = 0u;
    __syncthreads();
    if (MK_N_LAUNCHES == 1) (void)xcd_barrier_post((unsigned*)(args.ws + WS_CTL) + CW_BAR, MISC + 8);
#define PH_LO() ((&args.ph_lo)[opaque_zero()])
#define PH_HI() ((&args.ph_hi)[opaque_zero()])
#define IN(k) (PH_LO() <= (k) && (k) < PH_HI())
#define SEAM(k) do { if (IN(k) && IN((k) + 1)) { XcdBarrier bb_; bb_.bar = (unsigned*)((&args.ws)[opaque_zero()] + WS_CTL) + CW_BAR; bb_.x = xb_xcc_id(); \
        bb_.st = (volatile LAS unsigned*)(lds + MISC_OFF) + 8; xcd_barrier(bb_); } } while (0)

    if (EN(0) && IN(0)) p0_prologue(args, lds);
    SEAM(0);
    if (EN(1) && IN(1)) p0b_modreduce(args);
    SEAM(1);

    for (int l = 0; l < DEPTH; ++l) {
        const int pb = 2 + l * 8; const bool attn = (l & 1) == 0;
        if (EN(2) && IN(pb + 0)) { if (attn) norm_phase<0>(args, lds, l); else norm_phase<1>(args, lds, l); }
        SEAM(pb + 0);
        if (EN(3) && IN(pb + 1)) { if (attn) gemm_bf16_phase<0>(args, lds, l); else pooldiff_phase(args, l); }
        SEAM(pb + 1);
        if (EN(4) && IN(pb + 2)) { if (attn) attention_phase(args, lds, l >> 1); }
        if (attn) SEAM(pb + 2);
        if (EN(5) && IN(pb + 3)) gemm_resid_phase(args, lds, l, attn ? 0 : 1);
        SEAM(pb + 3);
        if (EN(6) && IN(pb + 4)) norm_phase<2>(args, lds, l);
        SEAM(pb + 4);
        if (EN(7) && IN(pb + 5)) gemm_bf16_phase<1>(args, lds, l);
        SEAM(pb + 5);
        if (EN(8) && IN(pb + 6)) convgate_phase(args, l);
        SEAM(pb + 6);
        if (EN(9) && IN(pb + 7)) gemm_resid_phase(args, lds, l, 2);
        SEAM(pb + 7);
    }
    if (EN(10) && IN(NPHASES - 1)) norm_phase<3>(args, lds, 0);
#undef IN
#undef SEAM
}

extern "C" void kernel_launch(void* const* d_in, const int* in_sizes, int n_in, void* d_out, int out_size, void* d_ws, size_t ws_size, hipStream_t stream) {
    static int grid = 0;
    if (grid == 0) {
        if (n_in != 15 || in_sizes[0] != M * DM || out_size != M * DM || ws_size < WS_END) { fprintf(stderr, "kernel_launch: unexpected shapes (n_in %d, in0 %d, out %d, ws %zu)\n", n_in, n_in > 0 ? in_sizes[0] : -1, out_size, ws_size); grid = -1; return; }
        int dev = 0, cus = 0, per_cu = 0;
        if (hipGetDevice(&dev) != hipSuccess || hipDeviceGetAttribute(&cus, hipDeviceAttributeMultiprocessorCount, dev) != hipSuccess) { grid = -1; return; }
        if (hipFuncSetAttribute((const void*)fwd_kernel, hipFuncAttributeMaxDynamicSharedMemorySize, LDS_BYTES) != hipSuccess) { fprintf(stderr, "kernel_launch: hipFuncSetAttribute failed\n"); grid = -1; return; }
        if (hipOccupancyMaxActiveBlocksPerMultiprocessor(&per_cu, (const void*)fwd_kernel, NWAVES * 64, LDS_BYTES) != hipSuccess || per_cu < 1) { fprintf(stderr, "kernel_launch: occupancy query says %d\n", per_cu); }
        (void)hipGetLastError();
        grid = cus;
    }
    if (grid < 0) return;
    (void)hipMemsetAsync((char*)d_ws + WS_CTL, 0, CTL_ZERO_BYTES, stream);
    Args a{};
    for (int i = 0; i < 15; ++i) a.in[i] = (const float*)d_in[i];
    a.out = (float*)d_out; a.ws = (unsigned char*)d_ws;
#if MK_N_LAUNCHES == 1
    a.ph_lo = 0; a.ph_hi = NPHASES;
    hipLaunchKernelGGL(fwd_kernel, dim3(grid), dim3(NWAVES * 64), LDS_BYTES, stream, a);
#else
    for (int p = 0; p < NPHASES; ++p) { a.ph_lo = p; a.ph_hi = p + 1; hipLaunchKernelGGL(fwd_kernel, dim3(grid), dim3(NWAVES * 64), LDS_BYTES, stream, a); }
#endif
}
```

```cpp
#include <hip/hip_runtime.h>
#include <cstdio>
#include <cstdint>

#ifndef MK_N_LAUNCHES
#define MK_N_LAUNCHES 1
#endif

constexpr int BATCH = 4, SEQ = 2048, DM = 2048, DEPTH = 4, NH = 16, HD = 128, NSB = 8, NFX = 8;
constexpr int M = BATCH * SEQ;
constexpr int DFF = 5632, F2 = 2 * DFF;
constexpr int NQKV = 3 * DM;
constexpr int NIN = NQKV + NFX;
constexpr int NMOD = 6 * DM;
constexpr float EPS = 1e-6f;
constexpr float LOG2E = 1.4426950408889634f;
constexpr float ATT_SCALE = 0.08838834764831845f;
constexpr float SB_EXIT = 1e-24f;

namespace pg8 {
#define PG8_LAS __attribute__((address_space(3)))
typedef unsigned short bf16_t;
typedef short bf16x8 __attribute__((ext_vector_type(8)));
typedef float f32x4 __attribute__((ext_vector_type(4)));
typedef unsigned u32x4 __attribute__((ext_vector_type(4)));
constexpr int BM = 256, BK = 64, HALF = 128, HTB = HALF * BK * 2, STAGE_BYTES = 8 * HTB, NXCD = 8, WGM = 8;

__host__ __device__ __forceinline__ int lds_byte(int r, int c) { const int st = (r >> 4) * 2 + (c >> 5), rr = r & 15, cc = c & 31, ob = rr * 64 + cc * 2; return st * 1024 + (ob ^ (((ob >> 9) & 1) << 5)); }
__host__ __device__ __forceinline__ void stage_rc(int b, int& R, int& C) { const int st = b / 1024, sb = b % 1024, swz = sb ^ (((sb >> 9) & 1) << 5); R = (st >> 1) * 16 + swz / 64; C = (st & 1) * 32 + (swz % 64) / 2; }
__host__ __device__ __forceinline__ int perm32(int rho) { const int n = rho >> 4, i = rho & 15; return 8 * (i >> 2) + 4 * n + (i & 3); }

struct Unit { int pm, pn; };
struct Gemm { const bf16_t* A; const bf16_t* Bt; int M, N, K, lda, grouped; };

struct StaticOrder {
    int nM, nN, nwg, G, c;
    __host__ __device__ void init(int M_, int N_, int G_, int c_) { nM = M_ / BM; nN = N_ / BM; nwg = nM * nN; G = G_; c = c_; }
    __host__ __device__ bool next(int i, Unit& u) const {
        const long L = (long)i * G + c; if (L >= nwg) return false;
        int wgid = (int)L; { const int q = nwg / NXCD, r = nwg % NXCD, xcd = wgid % NXCD, off = wgid / NXCD; wgid = (xcd < r ? xcd * (q + 1) : r * (q + 1) + (xcd - r) * q) + off; }
        const int nig = WGM * nN, gid = wgid / nig, fm = gid * WGM, gsz = (nM - fm) < WGM ? (nM - fm) : WGM;
        u.pm = fm + ((wgid % nig) % gsz); u.pn = (wgid % nig) / gsz; return true;
    }
    __device__ __forceinline__ void a_ready(const Unit&) const {}
    __device__ __forceinline__ void done(const Unit&) const {}
};

__device__ __forceinline__ unsigned cvt_pk_bf16(float lo, float hi) { unsigned r; asm volatile("v_cvt_pk_bf16_f32 %0, %1, %2" : "=v"(r) : "v"(lo), "v"(hi)); return r; }

struct EpiBf16 {
    static constexpr bool PERM = true, AFTER_DRAIN = false;
    bf16_t* O; int ldc; int split_cols; size_t split_stride;
    __device__ __forceinline__ void operator()(const f32x4 (&acc)[2][2][4][2], const Unit& u, int wr, int wc, int fr, int fq) const {
        const int row0 = u.pm * BM + wr * 64 + fr; int colt = u.pn * BM; bf16_t* base = O;
        if (split_cols) { const int t = colt / split_cols; base += (size_t)t * split_stride; colt -= t * split_cols; }
        const int col0 = colt + wc * 32 + 8 * fq;
#pragma unroll
        for (int ai = 0; ai < 2; ++ai)
#pragma unroll
            for (int m = 0; m < 4; ++m) { bf16_t* rowp = base + (size_t)(row0 + ai * HALF + m * 16) * ldc + col0;
#pragma unroll
                for (int bj = 0; bj < 2; ++bj) { const f32x4 v0 = acc[ai][bj][m][0], v1 = acc[ai][bj][m][1];
                    u32x4 w; w.x = cvt_pk_bf16(v0[0], v0[1]); w.y = cvt_pk_bf16(v0[2], v0[3]); w.z = cvt_pk_bf16(v1[0], v1[1]); w.w = cvt_pk_bf16(v1[2], v1[3]);
                    *(u32x4*)(rowp + bj * HALF) = w; } }
    }
};
struct EpiResid {
    static constexpr bool PERM = false, AFTER_DRAIN = false;
    const float* xin; float* xout; const float* gate; const float* pscale;
    __device__ __forceinline__ void operator()(const f32x4 (&acc)[2][2][4][2], const Unit& u, int wr, int wc, int fr, int fq) const {
        const int row0 = u.pm * BM + wr * 64 + fr, col0 = u.pn * BM + wc * 32 + 4 * fq; const int b = u.pm >> 3;
        f32x4 gv[2][2];
#pragma unroll
        for (int bj = 0; bj < 2; ++bj)
#pragma unroll
            for (int n = 0; n < 2; ++n) { gv[bj][n] = *(const f32x4*)(gate + (size_t)b * NMOD + col0 + bj * HALF + n * 16);
                if (pscale) gv[bj][n] = gv[bj][n] * *(const f32x4*)(pscale + col0 + bj * HALF + n * 16); }
#pragma unroll
        for (int ai = 0; ai < 2; ++ai)
#pragma unroll
            for (int m = 0; m < 4; ++m) { const size_t off = (size_t)(row0 + ai * HALF + m * 16) * DM + col0;
#pragma unroll
                for (int bj = 0; bj < 2; ++bj)
#pragma unroll
                    for (int n = 0; n < 2; ++n) { const f32x4 xv = *(const f32x4*)(xin + off + bj * HALF + n * 16);
                        *(f32x4*)(xout + off + bj * HALF + n * 16) = xv + gv[bj][n] * acc[ai][bj][m][n]; }
                asm volatile("" ::: "memory"); }
    }
};

template <class Epi, class Sched, bool ALIGN_EPI = false, bool SP2 = false>
__device__ __forceinline__ void gemm_phase(PG8_LAS unsigned char* lds, const Gemm g, const Sched& S, const Epi& E, const int tid) {
    const int wid = __builtin_amdgcn_readfirstlane(tid >> 6), lane = tid & 63, wr = wid >> 2, wc = wid & 3, fr = lane & 15, fq = lane >> 4;
    const int K = g.K, nt = K / BK, lda = g.lda;
    unsigned voffA[2], voffB[2];
#pragma unroll
    for (int i = 0; i < 2; ++i) { int R, C; stage_rc(tid * 16 + i * 8192, R, C); const int Rb = Epi::PERM ? ((R & ~31) + perm32(R & 31)) : R;
        voffA[i] = (unsigned)(R * lda + C) * 2u; voffB[i] = (unsigned)(Rb * K + C) * 2u; }
    const size_t kstep = (size_t)(BK * 2);
    const size_t hstepA = (size_t)HALF * lda * 2, hstepB = (size_t)HALF * K * 2;
    const size_t tstepA = 2 * hstepA, tstepB = 2 * hstepB;
    const unsigned ldsw = (unsigned)wid * 1024u;
    const int aoff = lds_byte(wr * 64 + fr, fq * 8), boff = lds_byte(wc * 32 + fr, fq * 8);
#define PG8_UA(u) ((const char*)g.A + (size_t)(u).pm * tstepA + (g.grouped ? (size_t)((u).pn >> 1) * (size_t)K * 2 : (size_t)0))
#define PG8_UB(u) ((const char*)g.Bt + (size_t)(u).pn * tstepB)
#define PG8_SA(b, h) (((b) * 2 + (h)) * HTB)
#define PG8_SB(b, h) ((4 + (b) * 2 + (h)) * HTB)
#define PG8_STAGE(bufoff, gbase, voff) do { _Pragma("unroll") for (int _i = 0; _i < 2; ++_i) \
        __builtin_amdgcn_global_load_lds((const unsigned*)((const char*)(gbase) + (voff)[_i]), (PG8_LAS unsigned*)(lds + (bufoff) + ldsw + _i * 8192), 16, 0, 0); } while (0)
#define PG8_LDA(dst, b, h) do { _Pragma("unroll") for (int m = 0; m < 4; ++m) _Pragma("unroll") for (int k = 0; k < 2; ++k) dst[m][k] = *(const PG8_LAS bf16x8*)(lds + PG8_SA(b, h) + aoff + m * 2048 + k * 1024); } while (0)
#define PG8_LDB(dst, b, h) do { _Pragma("unroll") for (int n = 0; n < 2; ++n) _Pragma("unroll") for (int k = 0; k < 2; ++k) dst[n][k] = *(const PG8_LAS bf16x8*)(lds + PG8_SB(b, h) + boff + n * 2048 + k * 1024); } while (0)
#define PG8_MMA(ai, bj, At, Bt) do { __builtin_amdgcn_s_setprio(1); _Pragma("unroll") for (int m = 0; m < 4; ++m) _Pragma("unroll") for (int n = 0; n < 2; ++n) _Pragma("unroll") for (int k = 0; k < 2; ++k) \
        acc[ai][bj][m][n] = __builtin_amdgcn_mfma_f32_16x16x32_bf16(Bt[n][k], At[m][k], acc[ai][bj][m][n], 0, 0, 0); __builtin_amdgcn_s_setprio(0); } while (0)
#define PG8_WAIT_V(n) asm volatile("s_waitcnt vmcnt(" #n ")" ::: "memory")
#define PG8_WAIT_L(n) asm volatile("s_waitcnt lgkmcnt(" #n ")" ::: "memory")
#define PG8_BAR __builtin_amdgcn_s_barrier()
#define PG8_SCHED __builtin_amdgcn_sched_barrier(0)
    Unit cur, nxt; int ui = 0;
    if (!S.next(0, cur)) return;
    f32x4 acc[2][2][4][2];
#pragma unroll
    for (int a = 0; a < 2; ++a)
#pragma unroll
        for (int b = 0; b < 2; ++b)
#pragma unroll
            for (int m = 0; m < 4; ++m)
#pragma unroll
                for (int n = 0; n < 2; ++n) acc[a][b][m][n] = (f32x4){0.f, 0.f, 0.f, 0.f};
    bf16x8 At[4][2], B0[2][2], B1[2][2];
    const char* cA = PG8_UA(cur); const char* cB = PG8_UB(cur);
    S.a_ready(cur);
    if constexpr (SP2) {
        PG8_STAGE(PG8_SB(0, 0), cB, voffB); PG8_STAGE(PG8_SB(0, 1), cB + hstepB, voffB); PG8_STAGE(PG8_SA(0, 0), cA, voffA); PG8_STAGE(PG8_SA(0, 1), cA + hstepA, voffA);
        if (wr == 1) PG8_BAR;
        PG8_WAIT_V(2); PG8_BAR;
        PG8_STAGE(PG8_SB(1, 0), cB + kstep, voffB); PG8_STAGE(PG8_SA(1, 0), cA + kstep, voffA); PG8_STAGE(PG8_SB(1, 1), cB + hstepB + kstep, voffB);
        PG8_WAIT_V(6); PG8_BAR;
    } else {
        PG8_STAGE(PG8_SB(0, 0), cB, voffB); PG8_STAGE(PG8_SA(0, 0), cA, voffA); PG8_STAGE(PG8_SB(0, 1), cB + hstepB, voffB); PG8_STAGE(PG8_SA(0, 1), cA + hstepA, voffA);
        if (wr == 1) PG8_BAR;
        PG8_WAIT_V(4); PG8_BAR;
        PG8_STAGE(PG8_SB(1, 0), cB + kstep, voffB); PG8_STAGE(PG8_SA(1, 0), cA + kstep, voffA); PG8_STAGE(PG8_SB(1, 1), cB + hstepB + kstep, voffB);
        PG8_WAIT_V(6); PG8_BAR;
    }
    for (;;) {
        const bool has_next = S.next(ui + 1, nxt);
        const char* nA = has_next ? PG8_UA(nxt) : cA; const char* nB = has_next ? PG8_UB(nxt) : cB;
        for (int t = 0; t < nt; t += 2) {
            const bool last = (t == nt - 2);
            const char* a1 = cA + (size_t)(t + 1) * kstep;
            const char* a2 = last ? nA : cA + (size_t)(t + 2) * kstep; const char* b2 = last ? nB : cB + (size_t)(t + 2) * kstep;
            const char* a3 = a2 + kstep; const char* b3 = b2 + kstep;
            if (last && has_next) S.a_ready(nxt);
            if constexpr (SP2) {
            PG8_LDB(B0, 0, 0); PG8_LDB(B1, 0, 1); PG8_SCHED; PG8_LDA(At, 0, 0); PG8_STAGE(PG8_SA(1, 1), a1 + hstepA, voffA);
            PG8_WAIT_V(8); PG8_WAIT_L(0); PG8_BAR; PG8_MMA(0, 0, At, B0); PG8_MMA(0, 1, At, B1); PG8_BAR; PG8_SCHED;
            PG8_LDA(At, 0, 1); PG8_STAGE(PG8_SB(0, 0), b2, voffB); PG8_STAGE(PG8_SB(0, 1), b2 + hstepB, voffB); PG8_STAGE(PG8_SA(0, 0), a2, voffA);
            PG8_WAIT_V(8); PG8_WAIT_L(0); PG8_BAR; PG8_MMA(1, 0, At, B0); PG8_MMA(1, 1, At, B1); PG8_BAR; PG8_SCHED;
            PG8_LDB(B0, 1, 0); PG8_LDB(B1, 1, 1); PG8_SCHED; PG8_LDA(At, 1, 0); PG8_STAGE(PG8_SA(0, 1), a2 + hstepA, voffA);
            PG8_WAIT_V(8); PG8_WAIT_L(0); PG8_BAR; PG8_MMA(0, 0, At, B0); PG8_MMA(0, 1, At, B1); PG8_BAR; PG8_SCHED;
            PG8_LDA(At, 1, 1); PG8_STAGE(PG8_SB(1, 0), b3, voffB); PG8_STAGE(PG8_SB(1, 1), b3 + hstepB, voffB); PG8_STAGE(PG8_SA(1, 0), a3, voffA);
            PG8_WAIT_V(8); PG8_WAIT_L(0); PG8_BAR; PG8_MMA(1, 0, At, B0); PG8_MMA(1, 1, At, B1); PG8_BAR; PG8_SCHED;
            } else {
            PG8_LDB(B0, 0, 0); PG8_SCHED; PG8_LDA(At, 0, 0); PG8_STAGE(PG8_SA(1, 1), a1 + hstepA, voffA);
            PG8_WAIT_L(8); PG8_BAR; PG8_WAIT_L(0); PG8_MMA(0, 0, At, B0); PG8_BAR; PG8_SCHED;
            PG8_LDB(B1, 0, 1); PG8_STAGE(PG8_SB(0, 0), b2, voffB);
            PG8_BAR; PG8_WAIT_L(0); PG8_MMA(0, 1, At, B1); PG8_BAR;
            PG8_LDA(At, 0, 1); PG8_STAGE(PG8_SA(0, 0), a2, voffA);
            PG8_BAR; PG8_WAIT_L(0); PG8_MMA(1, 0, At, B0); PG8_BAR; PG8_SCHED;
            PG8_STAGE(PG8_SB(0, 1), b2 + hstepB, voffB);
            PG8_WAIT_V(6); PG8_BAR; PG8_MMA(1, 1, At, B1); PG8_BAR;
            PG8_LDB(B0, 1, 0); PG8_SCHED; PG8_LDA(At, 1, 0); PG8_STAGE(PG8_SA(0, 1), a2 + hstepA, voffA);
            PG8_WAIT_L(8); PG8_BAR; PG8_WAIT_L(0); PG8_MMA(0, 0, At, B0); PG8_BAR; PG8_SCHED;
            PG8_LDB(B1, 1, 1); PG8_STAGE(PG8_SB(1, 0), b3, voffB);
            PG8_BAR; PG8_WAIT_L(0); PG8_MMA(0, 1, At, B1); PG8_BAR;
            PG8_LDA(At, 1, 1); PG8_STAGE(PG8_SA(1, 0), a3, voffA);
            PG8_BAR; PG8_WAIT_L(0); PG8_MMA(1, 0, At, B0); PG8_BAR; PG8_SCHED;
            PG8_STAGE(PG8_SB(1, 1), b3 + hstepB, voffB);
            PG8_WAIT_V(6); PG8_BAR; PG8_MMA(1, 1, At, B1); PG8_BAR;
            }
        }
        if constexpr (ALIGN_EPI) { if (wr == 0) PG8_BAR; }
        if constexpr (!Epi::AFTER_DRAIN) { E(acc, cur, wr, wc, fr, fq); S.done(cur); }
        if (!has_next) break;
#pragma unroll
        for (int a = 0; a < 2; ++a)
#pragma unroll
            for (int b = 0; b < 2; ++b)
#pragma unroll
                for (int m = 0; m < 4; ++m)
#pragma unroll
                    for (int n = 0; n < 2; ++n) acc[a][b][m][n] = (f32x4){0.f, 0.f, 0.f, 0.f};
        cur = nxt; cA = nA; cB = nB; ++ui;
        if constexpr (ALIGN_EPI) { if (wr == 1) PG8_BAR; }
    }
    PG8_WAIT_V(0);
    if constexpr (!ALIGN_EPI) { if (wr == 0) PG8_BAR; }
    PG8_BAR;
#undef PG8_UA
#undef PG8_UB
#undef PG8_SA
#undef PG8_SB
#undef PG8_STAGE
#undef PG8_LDA
#undef PG8_LDB
#undef PG8_MMA
#undef PG8_WAIT_V
#undef PG8_WAIT_L
#undef PG8_BAR
#undef PG8_SCHED
}
}

#define GAS __attribute__((address_space(1)))
#define LAS __attribute__((address_space(3)))
typedef unsigned short bf16;
typedef unsigned v4u __attribute__((ext_vector_type(4)));
typedef unsigned v2u __attribute__((ext_vector_type(2)));
typedef float f32x4 __attribute__((ext_vector_type(4)));
typedef float f32x16 __attribute__((ext_vector_type(16)));
typedef short bf16x8 __attribute__((ext_vector_type(8)));
typedef short s16x4 __attribute__((ext_vector_type(4)));
typedef GAS unsigned gu32;
#define RLX_AGENT __ATOMIC_RELAXED, __HIP_MEMORY_SCOPE_AGENT
#define LDS_WAIT() asm volatile("s_waitcnt lgkmcnt(0)" ::: "memory")
#define VM_WAIT() asm volatile("s_waitcnt vmcnt(0)" ::: "memory")
__device__ __forceinline__ unsigned pk2(float lo, float hi) { unsigned r; asm volatile("v_cvt_pk_bf16_f32 %0, %1, %2" : "=v"(r) : "v"(lo), "v"(hi)); return r; }
__device__ __forceinline__ float bflo(unsigned w) { return __uint_as_float(w << 16); }
__device__ __forceinline__ float bfhi(unsigned w) { return __uint_as_float(w & 0xffff0000u); }

#define XB_TMO      128
#define XB_XCNT(j)  (256  + 64 * (j))
#define XB_XSUB(j)  (1280 + 64 * (j))
#define XB_XGEN(j)  (2304 + 64 * (j))
#define XB_TOP      3328
#define XB_TOPGEN   3392
#define XCD_BAR_WORDS 3456
#define XB_SPIN_CAP (1u << 18)
__device__ __forceinline__ unsigned xb_ld(unsigned* p)              { return __hip_atomic_load(p, __ATOMIC_RELAXED, __HIP_MEMORY_SCOPE_AGENT); }
__device__ __forceinline__ unsigned xb_add(unsigned* p, unsigned v) { return __hip_atomic_fetch_add(p, v, __ATOMIC_RELAXED, __HIP_MEMORY_SCOPE_AGENT); }
__device__ __forceinline__ unsigned xb_xcc_id() { return (unsigned)__builtin_amdgcn_s_getreg((3 << 11) | 20) & 0xFu; }
#define XB_SPIN(cond, bar) do { unsigned _sp = 0; while (cond) { __builtin_amdgcn_s_sleep(1); \
    if ((++_sp & 255u) == 0u) { if (xb_ld(&(bar)[XB_TMO])) break; if (_sp > XB_SPIN_CAP) { atomicAdd(&(bar)[XB_TMO], 1u); break; } } } } while (0)
struct XcdBarrier { unsigned* bar; unsigned x; volatile LAS unsigned* st; };
__device__ __forceinline__ XcdBarrier xcd_barrier_post(unsigned* bar, volatile LAS unsigned* st) {
    XcdBarrier b; b.bar = bar; b.x = xb_xcc_id(); b.st = st;
    if (threadIdx.x == 0) (void)xb_add(&bar[XB_XCNT(b.x)], 1u);
    return b;
}
__device__ __forceinline__ void xcd_barrier_complete(unsigned* bar, unsigned x, unsigned& nloc, unsigned& nx) {
    const unsigned G = gridDim.x * gridDim.y * gridDim.z;
    unsigned sum, cnt, mine, sp = 0u;
    for (;;) {
        sum = 0u; cnt = 0u; mine = 0u;
#pragma unroll
        for (unsigned j = 0; j < 16; ++j) { const unsigned c = xb_ld(&bar[XB_XCNT(j)]); sum += c; cnt += (c > 0u) ? 1u : 0u; mine = (j == x) ? c : mine; }
        if (sum == G) break;
        __builtin_amdgcn_s_sleep(1);
        if ((++sp & 255u) == 0u) { if (xb_ld(&bar[XB_TMO])) break; if (sp > XB_SPIN_CAP) { atomicAdd(&bar[XB_TMO], 1u); break; } }
    }
    nloc = mine > 0u ? mine : 1u; nx = cnt > 0u ? cnt : 1u;
}
__device__ __forceinline__ void xcd_barrier(const XcdBarrier& b) {
    asm volatile("s_waitcnt vmcnt(0)" ::: "memory");
    __syncthreads();
    if (threadIdx.x == 0) {
        unsigned* bar = b.bar;
        __builtin_amdgcn_s_waitcnt(0);
        unsigned nloc = b.st[0], nx = b.st[1];
        if (nloc == 0u) { xcd_barrier_complete(bar, b.x, nloc, nx); b.st[0] = nloc; b.st[1] = nx; }
        const unsigned old = xb_add(&bar[XB_XSUB(b.x)], 1u);
        const unsigned gen = old / nloc;
        if (old + 1u == (gen + 1u) * nloc) {
            __builtin_amdgcn_fence(__ATOMIC_RELEASE, "agent");
            asm volatile("s_waitcnt vmcnt(0)" ::: "memory");
            const unsigned og = xb_add(&bar[XB_TOP], 1u);
            const unsigned tg = og / nx;
            if (og + 1u == (tg + 1u) * nx) xb_add(&bar[XB_TOPGEN], 1u);
            else XB_SPIN(xb_ld(&bar[XB_TOPGEN]) == tg, bar);
            __builtin_amdgcn_fence(__ATOMIC_ACQUIRE, "agent");
            xb_add(&bar[XB_XGEN(b.x)], 1u);
            asm volatile("s_waitcnt vmcnt(0)" ::: "memory");
        } else {
            XB_SPIN(xb_ld(&bar[XB_XGEN(b.x)]) == gen, bar);
            __builtin_amdgcn_fence(__ATOMIC_ACQUIRE, "agent");
            asm volatile("s_waitcnt vmcnt(0)" ::: "memory");
        }
    }
    __syncthreads();
}

constexpr size_t MiB = 1u << 20;
constexpr size_t WS_CTL = 0, CTL_ZERO_BYTES = 1 * MiB;
constexpr size_t WS_MOD = 1 * MiB;
constexpr size_t WS_RSTD = 2 * MiB;
constexpr size_t WS_FLOG = 3 * MiB;
constexpr size_t WS_MODP = 4 * MiB;
constexpr size_t WS_WIN = 32 * MiB;
constexpr size_t WS_WOUT = 80 * MiB;
constexpr size_t WS_WPOOL = 96 * MiB;
constexpr size_t WS_WUP = 100 * MiB;
constexpr size_t WS_WDOWN = 276 * MiB;
constexpr size_t WS_H = 364 * MiB;
constexpr size_t WS_Q = 396 * MiB, WS_K = 428 * MiB, WS_V = 460 * MiB;
constexpr size_t WS_AO = 492 * MiB;
constexpr size_t WS_U = 524 * MiB;
constexpr size_t WS_ACT = 700 * MiB;
constexpr size_t WS_END = 788 * MiB;
constexpr int CW_BAR = 4096;
constexpr int CW_QUEUE = 16384;

constexpr int SCR_BYTES = 133120;
constexpr int MISC_OFF = SCR_BYTES;
constexpr int LDS_BYTES = 147456;
constexpr int NWAVES = 8;


struct Args { const float* in[15]; float* out; unsigned char* ws; int ph_lo, ph_hi; };
enum { I_X = 0, I_C, I_WMOD, I_BMOD, I_GAIN, I_WIN, I_BF, I_WOUT, I_WPOOL, I_PSCALE, I_WUP, I_CONVW, I_CONVB, I_WDOWN, I_FGAIN };
__device__ __forceinline__ int opaque_zero() { int z = 0; asm volatile("" : "+s"(z)); return z; }
__device__ __forceinline__ int opaque_v(int v) { asm volatile("" : "+v"(v)); return v; }
__device__ __forceinline__ int opaque_s(int v) { asm volatile("" : "+s"(v)); return v; }
#define ARG_IN(k) (args.in[(k) + zz])
#define ARG_OUT() ((&args.out)[zz])
#define ARG_WS() ((&args.ws)[zz])
#define PHASE_LOCALS const int zz = opaque_zero(); const int tid = opaque_v((int)threadIdx.x), bid = opaque_s((int)blockIdx.x), lane = tid & 63, wave = __builtin_amdgcn_readfirstlane(tid >> 6), G = gridDim.x; unsigned char* const ws = ARG_WS(); (void)lane; (void)wave; (void)G; (void)ws; (void)bid

__device__ __forceinline__ float wave_sum(float v) {
#pragma unroll
    for (int o = 1; o < 64; o <<= 1) v += __shfl_xor(v, o);
    return v;
}
__device__ __forceinline__ float silu_f(float v) { return v / (1.f + __expf(-v)); }

__device__ __forceinline__ void transpose_tile(const float* W, int ldw, int K, bf16* WT, int k0, int n0, LAS float* scr, int lane) {
    const int kq = lane >> 4, nc = (lane & 15) * 4;
    f32x4 v[16];
#pragma unroll
    for (int i = 0; i < 16; ++i) v[i] = *(const GAS f32x4*)(W + (size_t)(k0 + 4 * i + kq) * ldw + n0 + nc);
#pragma unroll
    for (int i = 0; i < 16; ++i) { LAS float* s = scr + (4 * i + kq) * 65 + nc; s[0] = v[i].x; s[1] = v[i].y; s[2] = v[i].z; s[3] = v[i].w; }
    LDS_WAIT(); asm volatile("" ::: "memory");
    const int c = lane & 7, nr = lane >> 3;
#pragma unroll
    for (int j = 0; j < 8; ++j) { const int n = nr + 8 * j; const LAS float* s = scr + (8 * c) * 65 + n;
        v4u o; o.x = pk2(s[0 * 65], s[1 * 65]); o.y = pk2(s[2 * 65], s[3 * 65]); o.z = pk2(s[4 * 65], s[5 * 65]); o.w = pk2(s[6 * 65], s[7 * 65]);
        *(GAS v4u*)(WT + (size_t)(n0 + n) * K + k0 + 8 * c) = o; }
    LDS_WAIT(); asm volatile("" ::: "memory");
}
__device__ __forceinline__ void p0_prologue(const Args& args, LAS unsigned char* lds) {
    PHASE_LOCALS;
    LAS float* scr = (LAS float*)(lds + wave * 16640);
    const int gw = bid * NWAVES + wave, NGW = G * NWAVES;
    constexpr int MOD_ITEMS = DEPTH * 32 * (NMOD / 256);
    float* modp = (float*)(ws + WS_MODP);
    { const float* c_in = ARG_IN(I_C); const float* w_mod = ARG_IN(I_WMOD);
    for (int it = gw; it < MOD_ITEMS; it += NGW) {
        const int l = it / (32 * 48), rem = it % (32 * 48), kc = rem / 48, nb = rem % 48;
        const int k0 = kc * 64, n = nb * 256 + lane * 4;
        { f32x4 cb;
          cb.x = silu_f(c_in[0 * DM + k0 + lane]); cb.y = silu_f(c_in[1 * DM + k0 + lane]); cb.z = silu_f(c_in[2 * DM + k0 + lane]); cb.w = silu_f(c_in[3 * DM + k0 + lane]);
          *(LAS f32x4*)(scr + 4 * lane) = cb; }
        LDS_WAIT(); asm volatile("" ::: "memory");
        f32x4 acc[4] = {};
        const float* wp = w_mod + ((size_t)l * DM + k0) * NMOD + n;
#pragma unroll 16
        for (int kk = 0; kk < 64; ++kk) {
            const f32x4 w = *(const GAS f32x4*)(wp + (size_t)kk * NMOD);
            const f32x4 s = *(const LAS f32x4*)(scr + 4 * kk);
            acc[0] = acc[0] + w * s.x; acc[1] = acc[1] + w * s.y; acc[2] = acc[2] + w * s.z; acc[3] = acc[3] + w * s.w;
        }
        LDS_WAIT(); asm volatile("" ::: "memory");
#pragma unroll
        for (int b = 0; b < 4; ++b) *(GAS f32x4*)(modp + (((size_t)kc * DEPTH + l) * BATCH + b) * NMOD + n) = acc[b];
    } }
    constexpr int T_IN = (DM / 64) * (NQKV / 64), T_OUT = (DM / 64) * (DM / 64), T_POOL = 8 * 8, T_UP = (DM / 64) * (F2 / 64), T_DOWN = (DFF / 64) * (DM / 64);
    constexpr int E0 = 2 * T_IN, E1 = E0 + 2 * T_OUT, E2 = E1 + 8 * T_POOL, E3 = E2 + 4 * T_UP, T_ALL = E3 + 4 * T_DOWN;
    for (int it = gw; it < T_ALL; it += NGW) {
        const float* W; bf16* WT; int ldw, K, N, r;
        if (it < E0)      { const int i = it / T_IN;  r = it % T_IN;  W = ARG_IN(I_WIN) + (size_t)i * DM * NIN;  ldw = NIN; K = DM;  N = NQKV; WT = (bf16*)(ws + WS_WIN) + (size_t)i * NQKV * DM; }
        else if (it < E1) { const int q = it - E0, i = q / T_OUT;  r = q % T_OUT;  W = ARG_IN(I_WOUT) + (size_t)i * DM * DM;  ldw = DM;  K = DM;  N = DM;   WT = (bf16*)(ws + WS_WOUT) + (size_t)i * DM * DM; }
        else if (it < E2) { const int q = it - E1, i = q / T_POOL; r = q % T_POOL; W = ARG_IN(I_WPOOL) + (size_t)i * 512 * 512; ldw = 512; K = 512; N = 512;  WT = (bf16*)(ws + WS_WPOOL) + (size_t)i * 512 * 512; }
        else if (it < E3) { const int q = it - E2, i = q / T_UP;   r = q % T_UP;   W = ARG_IN(I_WUP) + (size_t)i * DM * F2;    ldw = F2;  K = DM;  N = F2;   WT = (bf16*)(ws + WS_WUP) + (size_t)i * F2 * DM; }
        else              { const int q = it - E3, i = q / T_DOWN; r = q % T_DOWN; W = ARG_IN(I_WDOWN) + (size_t)i * DFF * DM; ldw = DM;  K = DFF; N = DM;   WT = (bf16*)(ws + WS_WDOWN) + (size_t)i * DM * DFF; }
        const int nb = N / 64;
        transpose_tile(W, ldw, K, WT, (r / nb) * 64, (r % nb) * 64, scr, lane);
    }
}
__device__ __forceinline__ void p0b_modreduce(const Args& args) {
    PHASE_LOCALS;
    const float* modp = (const float*)(ws + WS_MODP); float* mod = (float*)(ws + WS_MOD); const float* b_mod = ARG_IN(I_BMOD);
    constexpr int TOT4 = DEPTH * BATCH * NMOD / 4;
    for (int i = bid * 512 + tid; i < TOT4; i += G * 512) {
        const int e = i * 4, l = e / (BATCH * NMOD), n = e % NMOD;
        f32x4 s = *(const GAS f32x4*)(b_mod + (size_t)l * NMOD + n);
#pragma unroll 8
        for (int kc = 0; kc < 32; ++kc) s = s + *(const GAS f32x4*)(modp + (size_t)kc * (DEPTH * BATCH * NMOD) + e);
        *(GAS f32x4*)(mod + e) = s;
    }
}

template <int MODE>
__device__ __forceinline__ void norm_phase(const Args& args, LAS unsigned char* lds, int l) {
    PHASE_LOCALS;
    const int li = l >> 1;
    const float* x = (l == 0 && MODE < 2) ? ARG_IN(I_X) : (const float*)ARG_OUT();
    const float* gain = (MODE == 3) ? ARG_IN(I_FGAIN) : ARG_IN(I_GAIN) + (size_t)(l * 2 + (MODE == 2 ? 1 : 0)) * DM;
    const float* modl = (const float*)(ws + WS_MOD) + (size_t)l * BATCH * NMOD;
    const int shift_off = (MODE == 2) ? 3 * DM : 0;
    LAS float* wg = (LAS float*)lds;
    if (MODE == 0) {
        const float* wgate = ARG_IN(I_WIN) + (size_t)li * DM * NIN;
        __syncthreads();
        for (int i = tid; i < DM * NFX; i += 512) { const int k = i >> 3, j = i & 7; wg[j * DM + k] = wgate[(size_t)k * NIN + NQKV + j]; }
        __syncthreads();
    }
    const int gw = bid * NWAVES + wave, NGW = G * NWAVES;
    bf16* Hb = (bf16*)(ws + WS_H); float* rstd_o = (float*)(ws + WS_RSTD); float* flog = (float*)(ws + WS_FLOG);
    for (int rb = gw; rb < M / 4; rb += NGW) {
        const int m0 = rb * 4, b = m0 / SEQ;
        f32x4 gv[8], sh[8];
        if (MODE != 1) {
#pragma unroll
            for (int j = 0; j < 8; ++j) { const int cidx = (lane + 64 * j) * 4;
                gv[j] = *(const GAS f32x4*)(gain + cidx);
                if (MODE != 3) { const f32x4 sc = *(const GAS f32x4*)(modl + (size_t)b * NMOD + shift_off + DM + cidx); gv[j] = gv[j] * (sc + 1.0f);
                                 sh[j] = *(const GAS f32x4*)(modl + (size_t)b * NMOD + shift_off + cidx); } }
        }
        for (int rr = 0; rr < 4; ++rr) {
            const int m = m0 + rr;
            const GAS f32x4* xr = (const GAS f32x4*)(x + (size_t)m * DM) + lane;
            f32x4 v[8]; float ss = 0.f;
#pragma unroll
            for (int j = 0; j < 8; ++j) { v[j] = xr[64 * j]; ss += (v[j].x * v[j].x + v[j].y * v[j].y) + (v[j].z * v[j].z + v[j].w * v[j].w); }
            const float rstd = 1.0f / sqrtf(wave_sum(ss) * (1.0f / DM) + EPS);
            if (MODE == 1) { if (lane == 0) rstd_o[m] = rstd; continue; }
            if (MODE == 3) {
                GAS f32x4* o = (GAS f32x4*)(ARG_OUT() + (size_t)m * DM) + lane;
#pragma unroll
                for (int j = 0; j < 8; ++j) o[64 * j] = v[j] * rstd * gv[j];
                continue;
            }
#pragma unroll
            for (int j = 0; j < 8; ++j) v[j] = v[j] * rstd * gv[j] + sh[j];
            GAS v2u* o8 = (GAS v2u*)(Hb + (size_t)m * DM) + lane;
#pragma unroll
            for (int j = 0; j < 8; ++j) { v2u w; w.x = pk2(v[j].x, v[j].y); w.y = pk2(v[j].z, v[j].w); o8[64 * j] = w; }
            if (MODE == 0) {
                float g8[8];
#pragma unroll
                for (int q = 0; q < 8; ++q) { float a = 0.f;
#pragma unroll
                    for (int j = 0; j < 8; ++j) { const f32x4 w = *(const LAS f32x4*)(wg + q * DM + (lane + 64 * j) * 4); a += (v[j].x * w.x + v[j].y * w.y) + (v[j].z * w.z + v[j].w * w.w); }
                    g8[q] = wave_sum(a); }
                if (lane < 8) { float f = 0.f;
#pragma unroll
                    for (int q = 0; q < 8; ++q) f = (lane == q) ? g8[q] : f;
                    f += ARG_IN(I_BF)[li * NFX + lane];
                    const float ls = fminf(f, 0.f) - log1pf(expf(-fabsf(f)));
                    flog[((size_t)b * NFX + lane) * SEQ + (m - b * SEQ)] = ls; }
            }
        }
    }
}

__device__ __forceinline__ void pooldiff_phase(const Args& args, int l) {
    PHASE_LOCALS;
    const float* x = (const float*)ARG_OUT();
    const float* gain = ARG_IN(I_GAIN) + (size_t)(l * 2) * DM;
    const float* modl = (const float*)(ws + WS_MOD) + (size_t)l * BATCH * NMOD;
    const int gw = bid * NWAVES + wave, NGW = G * NWAVES;
    const float* rstd = (const float*)(ws + WS_RSTD); bf16* Hb = (bf16*)(ws + WS_H);
    for (int it = gw; it < (M / 16) * 4; it += NGW) {
        const int grp = it & 3, chunk = it >> 2, t0 = chunk * 16, b = t0 / SEQ, tp0 = t0 - b * SEQ;
        const int w = 2 << grp;
        const int col = grp * 512 + lane * 8;
        f32x4 g0 = *(const GAS f32x4*)(gain + col), g1 = *(const GAS f32x4*)(gain + col + 4);
        g0 = g0 * (*(const GAS f32x4*)(modl + (size_t)b * NMOD + DM + col) + 1.0f); g1 = g1 * (*(const GAS f32x4*)(modl + (size_t)b * NMOD + DM + col + 4) + 1.0f);
        f32x4 s0 = {0.f, 0.f, 0.f, 0.f}, s1 = {0.f, 0.f, 0.f, 0.f};
        int tstart = tp0 - w; if (tstart < 0) tstart = 0;
        for (int tp = tstart; tp < tp0; ++tp) { const size_t m = (size_t)b * SEQ + tp; const float r = rstd[m];
            s0 = s0 + *(const GAS f32x4*)(x + m * DM + col) * r; s1 = s1 + *(const GAS f32x4*)(x + m * DM + col + 4) * r; }
        for (int i = 0; i < 16; ++i) { const int tp = tp0 + i; const size_t m = (size_t)b * SEQ + tp; const float r = rstd[m];
            const f32x4 y0 = *(const GAS f32x4*)(x + m * DM + col) * r, y1 = *(const GAS f32x4*)(x + m * DM + col + 4) * r;
            s0 = s0 + y0; s1 = s1 + y1;
            if (tp >= w) { const size_t mo = m - w; const float ro = rstd[mo];
                s0 = s0 - *(const GAS f32x4*)(x + mo * DM + col) * ro; s1 = s1 - *(const GAS f32x4*)(x + mo * DM + col + 4) * ro; }
            const float inv = 1.0f / (float)((tp + 1 < w) ? (tp + 1) : w);
            const f32x4 d0 = (s0 * inv - y0) * g0, d1 = (s1 * inv - y1) * g1;
            v4u o; o.x = pk2(d0.x, d0.y); o.y = pk2(d0.z, d0.w); o.z = pk2(d1.x, d1.y); o.w = pk2(d1.z, d1.w);
            *(GAS v4u*)(Hb + m * DM + col) = o; }
    }
}

__device__ __forceinline__ void convgate_phase(const Args& args, int l) {
    PHASE_LOCALS;
    const float* cw = ARG_IN(I_CONVW) + (size_t)l * 3 * F2; const float* cb = ARG_IN(I_CONVB) + (size_t)l * F2;
    const int gw = bid * NWAVES + wave, NGW = G * NWAVES;
    const bf16* U = (const bf16*)(ws + WS_U); bf16* A = (bf16*)(ws + WS_ACT);
    constexpr int NCB = DFF / 512;
    for (int it = gw; it < (M / 16) * NCB; it += NGW) {
        const int cbk = it % NCB, chunk = it / NCB, t0 = chunk * 16, tp0 = t0 % SEQ;
        const int col = cbk * 512 + lane * 8;
        float wa[3][8], wgt[3][8], ba[8], bg[8];
#pragma unroll
        for (int i = 0; i < 3; ++i) {
            const f32x4 a0 = *(const GAS f32x4*)(cw + (size_t)i * F2 + col), a1 = *(const GAS f32x4*)(cw + (size_t)i * F2 + col + 4);
            const f32x4 b0 = *(const GAS f32x4*)(cw + (size_t)i * F2 + DFF + col), b1 = *(const GAS f32x4*)(cw + (size_t)i * F2 + DFF + col + 4);
            wa[i][0] = a0.x; wa[i][1] = a0.y; wa[i][2] = a0.z; wa[i][3] = a0.w; wa[i][4] = a1.x; wa[i][5] = a1.y; wa[i][6] = a1.z; wa[i][7] = a1.w;
            wgt[i][0] = b0.x; wgt[i][1] = b0.y; wgt[i][2] = b0.z; wgt[i][3] = b0.w; wgt[i][4] = b1.x; wgt[i][5] = b1.y; wgt[i][6] = b1.z; wgt[i][7] = b1.w; }
        { const f32x4 a0 = *(const GAS f32x4*)(cb + col), a1 = *(const GAS f32x4*)(cb + col + 4), b0 = *(const GAS f32x4*)(cb + DFF + col), b1 = *(const GAS f32x4*)(cb + DFF + col + 4);
          ba[0] = a0.x; ba[1] = a0.y; ba[2] = a0.z; ba[3] = a0.w; ba[4] = a1.x; ba[5] = a1.y; ba[6] = a1.z; ba[7] = a1.w;
          bg[0] = b0.x; bg[1] = b0.y; bg[2] = b0.z; bg[3] = b0.w; bg[4] = b1.x; bg[5] = b1.y; bg[6] = b1.z; bg[7] = b1.w; }
        v4u pa2 = {0u, 0u, 0u, 0u}, pa1 = {0u, 0u, 0u, 0u}, pg2 = {0u, 0u, 0u, 0u}, pg1 = {0u, 0u, 0u, 0u};
        if (tp0 >= 2) { const bf16* r2 = U + (size_t)(t0 - 2) * F2 + col; const bf16* r1 = U + (size_t)(t0 - 1) * F2 + col;
            pa2 = *(const GAS v4u*)r2; pg2 = *(const GAS v4u*)(r2 + DFF); pa1 = *(const GAS v4u*)r1; pg1 = *(const GAS v4u*)(r1 + DFF); }
#pragma unroll 4
        for (int i = 0; i < 16; ++i) {
            const bf16* r0 = U + (size_t)(t0 + i) * F2 + col;
            const v4u ca = *(const GAS v4u*)r0, cg = *(const GAS v4u*)(r0 + DFF);
            unsigned ow[4];
#pragma unroll
            for (int q = 0; q < 4; ++q) {
                const float ya0 = ba[2 * q] + wa[0][2 * q] * bflo(pa2[q]) + wa[1][2 * q] * bflo(pa1[q]) + wa[2][2 * q] * bflo(ca[q]);
                const float ya1 = ba[2 * q + 1] + wa[0][2 * q + 1] * bfhi(pa2[q]) + wa[1][2 * q + 1] * bfhi(pa1[q]) + wa[2][2 * q + 1] * bfhi(ca[q]);
                const float yg0 = bg[2 * q] + wgt[0][2 * q] * bflo(pg2[q]) + wgt[1][2 * q] * bflo(pg1[q]) + wgt[2][2 * q] * bflo(cg[q]);
                const float yg1 = bg[2 * q + 1] + wgt[0][2 * q + 1] * bfhi(pg2[q]) + wgt[1][2 * q + 1] * bfhi(pg1[q]) + wgt[2][2 * q + 1] * bfhi(cg[q]);
                ow[q] = pk2(silu_f(yg0) * ya0, silu_f(yg1) * ya1); }
            v4u o; o.x = ow[0]; o.y = ow[1]; o.z = ow[2]; o.w = ow[3];
            *(GAS v4u*)(A + (size_t)(t0 + i) * DFF + col) = o;
            pa2 = pa1; pa1 = ca; pg2 = pg1; pg1 = cg;
        }
    }
}

namespace att {
constexpr int KVBLK = 64, QBLK = 32, QB = 256, SHM_V = KVBLK * HD * 2, SHM_K = KVBLK * HD * 2;
constexpr int OFF_V = 0, OFF_K = 2 * SHM_V, OFF_FS = 65536, OFF_WS = OFF_FS + 8192, OFF_FLAGS = OFF_WS + 2048, OFF_SCAN = OFF_FLAGS + 64, ATT_LDS = OFF_SCAN + 64;
#define KSWZ(row, colB) ((row) * 256 + ((colB) ^ (((row) & 7) << 4)))
#define SBAR() __builtin_amdgcn_sched_barrier(0)
__device__ __forceinline__ int v_st(int k, int c) { const int kk = (k & ~0xC) | ((k & 4) << 1) | ((k & 8) >> 1); return ((kk >> 3) * 4 + (c >> 5)) * 512 + ((kk & 7) * 32 + (c & 31)) * 2; }
__device__ __forceinline__ int v_rd_base(int lane) { return ((lane & 3) << 3) | (((lane >> 2) & 3) << 6) | (((lane >> 4) & 1) << 5) | (((lane >> 5) & 1) << 8); }
constexpr int v_rd_off(int d0, int ks, int half) { return d0 * 512 + ks * 4096 + half * 2048; }
__device__ __forceinline__ int crow(int r, int hi) { return (r & 3) + 8 * (r >> 2) + 4 * hi; }
__device__ __forceinline__ unsigned cvtpk(float lo, float hi) { unsigned r; asm volatile("v_cvt_pk_bf16_f32 %0, %1, %2" : "=v"(r) : "v"(lo), "v"(hi)); return r; }

__device__ __forceinline__ void qkt(f32x16& p0, f32x16& p1, const LAS unsigned char* kbase, int r32, int hi, const bf16x8* qr) {
    p0 = f32x16{}; p1 = f32x16{};
    const LAS unsigned char* kb[4];
#pragma unroll
    for (int dd = 0; dd < 4; ++dd) kb[dd] = kbase + KSWZ(r32, (dd * 16 + hi * 8) * 2);
#pragma unroll
    for (int d0 = 0; d0 < 8; ++d0) { const LAS unsigned char* a = kb[d0 & 3] + (d0 >> 2) * 128;
        const bf16x8 b0 = *(const LAS bf16x8*)a;
        const bf16x8 b1 = *(const LAS bf16x8*)(a + 32 * 256);
        p0 = __builtin_amdgcn_mfma_f32_32x32x16_bf16(b0, qr[d0], p0, 0, 0, 0);
        p1 = __builtin_amdgcn_mfma_f32_32x32x16_bf16(b1, qr[d0], p1, 0, 0, 0); }
}
__device__ __forceinline__ void pv_tile(f32x16* o, unsigned vb0, bf16x8 pa0, bf16x8 pa1, bf16x8 pa2, bf16x8 pa3) {
#define TRRD(dst, off) asm volatile("ds_read_b64_tr_b16 %0, %1 offset:%2" : "=&v"(dst) : "v"(vb0), "i"(off) : "memory")
#define PV_D0(d0) do { s16x4 l0, l1, l2, l3, h0, h1, h2, h3; constexpr int b_ = v_rd_off(d0, 0, 0); \
        TRRD(l0, b_); TRRD(h0, b_ + 2048); TRRD(l1, b_ + 4096); TRRD(h1, b_ + 6144); TRRD(l2, b_ + 8192); TRRD(h2, b_ + 10240); TRRD(l3, b_ + 12288); TRRD(h3, b_ + 14336); \
        asm volatile("s_waitcnt lgkmcnt(0)" ::: "memory"); SBAR(); \
        o[d0] = __builtin_amdgcn_mfma_f32_32x32x16_bf16(pa0, (bf16x8){l0[0], l0[1], l0[2], l0[3], h0[0], h0[1], h0[2], h0[3]}, o[d0], 0, 0, 0); \
        o[d0] = __builtin_amdgcn_mfma_f32_32x32x16_bf16(pa1, (bf16x8){l1[0], l1[1], l1[2], l1[3], h1[0], h1[1], h1[2], h1[3]}, o[d0], 0, 0, 0); \
        o[d0] = __builtin_amdgcn_mfma_f32_32x32x16_bf16(pa2, (bf16x8){l2[0], l2[1], l2[2], l2[3], h2[0], h2[1], h2[2], h2[3]}, o[d0], 0, 0, 0); \
        o[d0] = __builtin_amdgcn_mfma_f32_32x32x16_bf16(pa3, (bf16x8){l3[0], l3[1], l3[2], l3[3], h3[0], h3[1], h3[2], h3[3]}, o[d0], 0, 0, 0); } while (0)
    PV_D0(0); PV_D0(1); PV_D0(2); PV_D0(3);
#undef PV_D0
#undef TRRD
}
#define PK4(P, B_, OUT) do { unsigned a0 = cvtpk(P[B_+0], P[B_+1]), a1 = cvtpk(P[B_+2], P[B_+3]); \
        unsigned b0 = cvtpk(P[B_+4], P[B_+5]), b1 = cvtpk(P[B_+6], P[B_+7]); \
        auto r0 = __builtin_amdgcn_permlane32_swap(a0, b0, false, false); auto r1 = __builtin_amdgcn_permlane32_swap(a1, b1, false, false); \
        v4u w = {r0[0], r1[0], r0[1], r1[1]}; OUT = __builtin_bit_cast(bf16x8, w); } while (0)

template <bool FOX>
__device__ __forceinline__ void unit(LAS unsigned char* lds, const bf16* Q, const bf16* K, const bf16* V, bf16* O, const float* flog_bh, int b, int h, int qb, const int tid) {
    const int wid = __builtin_amdgcn_readfirstlane(tid >> 6), lane = tid & 63, r32 = lane & 31, hi = lane >> 5;
    const size_t rowbase = (size_t)b * SEQ;
    const int P0 = qb * QB, qlo = P0 + wid * QBLK, tpos = qlo + r32;
    LAS float* Fs = (LAS float*)(lds + OFF_FS);
    LAS float* wsf = (LAS float*)(lds + OFF_WS) + wid * 64; LAS float* li_l = wsf; LAS float* al_l = wsf + 32;
    volatile LAS int* flags = (volatile LAS int*)(lds + OFF_FLAGS);
    LAS float* scanp = (LAS float*)(lds + OFF_SCAN);
    const unsigned ldsb = (unsigned)(uintptr_t)lds;
    __syncthreads();
    if (FOX) {
        f32x4 v = *(const GAS f32x4*)(flog_bh + 4 * tid);
        v.y += v.x; v.z += v.y; v.w += v.z;
        float inc = v.w;
#pragma unroll
        for (int o = 1; o < 64; o <<= 1) { const float t = __shfl_up(inc, o); if (lane >= o) inc += t; }
        if (lane == 63) scanp[wid] = inc;
        __syncthreads();
        float off = inc - v.w;
#pragma unroll
        for (int w = 0; w < 8; ++w) off += (w < wid) ? scanp[w] : 0.f;
        *(LAS f32x4*)(Fs + 4 * tid) = (v + off) * LOG2E;
    }
    bf16x8 qr[8];
    { const bf16* qp = Q + (rowbase + tpos) * DM + h * HD + hi * 8;
#pragma unroll
      for (int d0 = 0; d0 < 8; ++d0) qr[d0] = *(const GAS bf16x8*)(qp + d0 * 16); }
    const int sr = tid >> 4, sc = (tid & 15) * 8;
    const unsigned vst0 = v_st(sr, sc), vst1 = v_st(32 + sr, sc), kws = KSWZ(sr, sc * 2);
    const bf16* Kh = K + rowbase * DM + h * HD + sc; const bf16* Vh = V + rowbase * DM + h * HD + sc;
    const unsigned vrd = ldsb + OFF_V + v_rd_base(lane);
    bf16x8 st_k0, st_k1, st_v0, st_v1;
#define SLOAD(k0) do { st_k0 = *(const GAS bf16x8*)(Kh + (size_t)((k0) + sr) * DM); st_k1 = *(const GAS bf16x8*)(Kh + (size_t)((k0) + 32 + sr) * DM); \
                       st_v0 = *(const GAS bf16x8*)(Vh + (size_t)((k0) + sr) * DM); st_v1 = *(const GAS bf16x8*)(Vh + (size_t)((k0) + 32 + sr) * DM); } while (0)
#define SWRITE(bf) do { *(LAS bf16x8*)(lds + OFF_K + (bf) * SHM_K + kws) = st_k0; *(LAS bf16x8*)(lds + OFF_K + (bf) * SHM_K + kws + 32 * 256) = st_k1; \
                        *(LAS bf16x8*)(lds + OFF_V + (bf) * SHM_V + vst0) = st_v0; *(LAS bf16x8*)(lds + OFF_V + (bf) * SHM_V + vst1) = st_v1; } while (0)
    int jt = (P0 + QB - 1) / KVBLK;
    SLOAD(jt * KVBLK); VM_WAIT(); SWRITE(0);
    __syncthreads();
    f32x16 o[4] = {};
    float m_reg = -1e30f, l_reg = 0.f, R = 1.0f;
    const float Ft2 = FOX ? Fs[tpos] : 0.f;
    constexpr float C2 = LOG2E * ATT_SCALE;
    int buf = 0, it = 0; bool wdone = false;
    for (;;) {
        const int kb = jt * KVBLK;
        const bool more = jt > 0;
        if (more) SLOAD(kb - KVBLK);
        const bool act = FOX ? (kb <= qlo + QBLK - 1) : (kb <= qlo + QBLK - 2 && !wdone);
        if (act) {
            f32x16 p0, p1;
            qkt(p0, p1, lds + OFF_K + buf * SHM_K, r32, hi, qr);
            bf16x8 pa0, pa1, pa2, pa3;
            if (FOX) {
#pragma unroll
                for (int g = 0; g < 4; ++g) { const f32x4 f0 = *(const LAS f32x4*)(Fs + kb + 8 * g + 4 * hi), f1 = *(const LAS f32x4*)(Fs + kb + 32 + 8 * g + 4 * hi);
#pragma unroll
                    for (int e = 0; e < 4; ++e) { p0[4 * g + e] = fmaf(p0[4 * g + e], C2, Ft2 - f0[e]); p1[4 * g + e] = fmaf(p1[4 * g + e], C2, Ft2 - f1[e]); } }
                if (kb + KVBLK - 1 > qlo) {
                    const float NEG = -__builtin_inff(); const int dq = tpos - kb - 4 * hi;
#pragma unroll
                    for (int r = 0; r < 16; ++r) { const int c = (r & 3) + 8 * (r >> 2); if (c > dq) p0[r] = NEG; if (c + 32 > dq) p1[r] = NEG; }
                }
                float pmax = p0[0];
#pragma unroll
                for (int r = 1; r < 16; ++r) pmax = fmaxf(pmax, p0[r]);
#pragma unroll
                for (int r = 0; r < 16; ++r) pmax = fmaxf(pmax, p1[r]);
                { auto rr = __builtin_amdgcn_permlane32_swap(__float_as_uint(pmax), __float_as_uint(pmax), false, false); pmax = fmaxf(__uint_as_float(rr[0]), __uint_as_float(rr[1])); }
                const float mn = fmaxf(m_reg, pmax); const float alpha = __builtin_amdgcn_exp2f(m_reg - mn); m_reg = mn;
                float ps = 0.f;
#pragma unroll
                for (int r = 0; r < 16; ++r) { p0[r] = __builtin_amdgcn_exp2f(p0[r] - mn); p1[r] = __builtin_amdgcn_exp2f(p1[r] - mn); ps += p0[r] + p1[r]; }
                { auto rr = __builtin_amdgcn_permlane32_swap(__float_as_uint(ps), __float_as_uint(ps), false, false); ps = __uint_as_float(rr[0]) + __uint_as_float(rr[1]); }
                l_reg = l_reg * alpha + ps;
                if (__any(alpha < 1.f)) { if (hi == 0) al_l[r32] = alpha; LDS_WAIT();
#pragma unroll
                    for (int r = 0; r < 16; ++r) { const float a = al_l[crow(r, hi)];
#pragma unroll
                        for (int d_ = 0; d_ < 4; ++d_) o[d_][r] *= a; } }
            } else {
                const int dq = tpos - kb - 4 * hi;
                const bool needmask = (kb + KVBLK - 1 >= qlo);
#pragma unroll
                for (int r = 0; r < 16; ++r) { const int c = (r & 3) + 8 * (r >> 2);
                    const float u0 = __builtin_amdgcn_exp2f(fminf(p0[r] * C2, 115.f)), u1 = __builtin_amdgcn_exp2f(fminf(p1[r] * C2, 115.f));
                    float r0 = __builtin_amdgcn_rcpf(1.0f + u0), r1 = __builtin_amdgcn_rcpf(1.0f + u1);
                    if (needmask) { if (c >= dq) r0 = 1.0f; if (c + 32 >= dq) r1 = 1.0f; }
                    p0[r] = r0; p1[r] = r1; }
                float og[8], pg[8];
#pragma unroll
                for (int i = 0; i < 4; ++i) { og[i] = (p0[4 * i] * p0[4 * i + 1]) * (p0[4 * i + 2] * p0[4 * i + 3]); og[4 + i] = (p1[4 * i] * p1[4 * i + 1]) * (p1[4 * i + 2] * p1[4 * i + 3]); }
#pragma unroll
                for (int i = 0; i < 8; ++i) { auto rr = __builtin_amdgcn_permlane32_swap(__float_as_uint(og[i]), __float_as_uint(og[i]), false, false);
                    pg[i] = hi ? __uint_as_float(rr[0]) : __uint_as_float(rr[1]); }
                float Srun = R;
#pragma unroll
                for (int j = 7; j >= 0; --j) {
                    const float ex = hi ? Srun : Srun * pg[j];
                    Srun = Srun * og[j] * pg[j];
                    if (j >= 4) { const int i = j - 4; const float e3 = ex, e2 = e3 * p1[4 * i + 3], e1 = e2 * p1[4 * i + 2], e0 = e1 * p1[4 * i + 1];
                        p1[4 * i] = (1.0f - p1[4 * i]) * e0; p1[4 * i + 1] = (1.0f - p1[4 * i + 1]) * e1; p1[4 * i + 2] = (1.0f - p1[4 * i + 2]) * e2; p1[4 * i + 3] = (1.0f - p1[4 * i + 3]) * e3; }
                    else { const int i = j; const float e3 = ex, e2 = e3 * p0[4 * i + 3], e1 = e2 * p0[4 * i + 2], e0 = e1 * p0[4 * i + 1];
                        p0[4 * i] = (1.0f - p0[4 * i]) * e0; p0[4 * i + 1] = (1.0f - p0[4 * i + 1]) * e1; p0[4 * i + 2] = (1.0f - p0[4 * i + 2]) * e2; p0[4 * i + 3] = (1.0f - p0[4 * i + 3]) * e3; }
                }
                R = Srun;
                wdone = __all(R < SB_EXIT);
            }
            PK4(p0, 0, pa0); PK4(p0, 8, pa1); PK4(p1, 0, pa2); PK4(p1, 8, pa3);
            pv_tile(o, vrd + buf * SHM_V, pa0, pa1, pa2, pa3);
        }
        if (!FOX) { if (lane == 0) flags[(it & 1) * 8 + wid] = wdone ? 1 : 0; }
        if (more) { VM_WAIT(); SWRITE(buf ^ 1); }
        __syncthreads();
        if (!more) break;
        if (!FOX) { int alld = 1;
#pragma unroll
            for (int w = 0; w < 8; ++w) alld &= flags[(it & 1) * 8 + w];
            if (alld) break; }
        buf ^= 1; --jt; ++it;
    }
#undef SLOAD
#undef SWRITE
    float rli[16];
    if (FOX) { if (hi == 0) li_l[r32] = l_reg; LDS_WAIT();
#pragma unroll
        for (int r = 0; r < 16; ++r) rli[r] = __builtin_amdgcn_rcpf(li_l[crow(r, hi)]); }
    bf16* Ow = O + (rowbase + qlo) * DM + h * HD;
#pragma unroll
    for (int r = 0; r < 16; ++r) { const int orow = crow(r, hi);
#pragma unroll
        for (int d0 = 0; d0 < 4; ++d0) { const float v = FOX ? o[d0][r] * rli[r] : o[d0][r];
            const float vn = __shfl_xor(v, 1);
            if ((r32 & 1) == 0) *(GAS unsigned*)(Ow + (size_t)orow * DM + d0 * 32 + r32) = cvtpk(v, vn); } }
}
#undef PK4
}

__device__ __forceinline__ void attention_phase(const Args& args, LAS unsigned char* lds, int li) {
    PHASE_LOCALS;
    volatile LAS unsigned* MISC = (volatile LAS unsigned*)(lds + MISC_OFF);
    const bf16* Q = (const bf16*)(ws + WS_Q); const bf16* K = (const bf16*)(ws + WS_K); const bf16* V = (const bf16*)(ws + WS_V); bf16* O = (bf16*)(ws + WS_AO);
    const float* flog = (const float*)(ws + WS_FLOG);
    gu32* head = (gu32*)(ws + WS_CTL) + CW_QUEUE + 64 * li;
    for (;;) {
        __syncthreads();
        if (tid == 0) MISC[16] = __hip_atomic_fetch_add(head, 1u, RLX_AGENT);
        __syncthreads();
        const int item = (int)MISC[16];
        if (item >= 512) break;
        const int fox = item < 256 ? 1 : 0, r = item & 255, qb = 7 - (r >> 5), bh = r & 31, b = bh >> 3, h = (bh & 7) + (fox ? NSB : 0);
        if (fox) att::unit<true>(lds, Q, K, V, O, flog + ((size_t)b * NFX + (h - NSB)) * SEQ, b, h, qb, tid);
        else att::unit<false>(lds, Q, K, V, O, flog, b, h, qb, tid);
    }
}

template <int KIND>
__device__ __forceinline__ void gemm_bf16_phase(const Args& args, LAS unsigned char* lds, int l) {
    PHASE_LOCALS;
    const bf16* Hb = (const bf16*)(ws + WS_H);
    if (KIND == 0) {
        pg8::Gemm g{Hb, (const bf16*)(ws + WS_WIN) + (size_t)(l >> 1) * NQKV * DM, M, NQKV, DM, DM, 0};
        pg8::StaticOrder S; S.init(M, NQKV, G, bid);
        pg8::EpiBf16 E{(bf16*)(ws + WS_Q), DM, DM, (size_t)M * DM};
        pg8::gemm_phase<pg8::EpiBf16, pg8::StaticOrder, true, true>(lds, g, S, E, tid);
    } else {
        pg8::Gemm g{Hb, (const bf16*)(ws + WS_WUP) + (size_t)l * F2 * DM, M, F2, DM, DM, 0};
        pg8::StaticOrder S; S.init(M, F2, G, bid);
        pg8::EpiBf16 E{(bf16*)(ws + WS_U), F2, 0, 0};
        pg8::gemm_phase<pg8::EpiBf16, pg8::StaticOrder, true, true>(lds, g, S, E, tid);
    }
}
__device__ __forceinline__ void gemm_resid_phase(const Args& args, LAS unsigned char* lds, int l, int kind) {
    PHASE_LOCALS;
    const int li = l >> 1;
    const float* modl = (const float*)(ws + WS_MOD) + (size_t)l * BATCH * NMOD;
    float* out = ARG_OUT();
    pg8::Gemm g; pg8::EpiResid E{out, out, modl + (kind == 2 ? 5 * DM : 2 * DM), nullptr};
    if (kind == 0) { g = pg8::Gemm{(const bf16*)(ws + WS_AO), (const bf16*)(ws + WS_WOUT) + (size_t)li * DM * DM, M, DM, DM, DM, 0}; if (l == 0) E.xin = ARG_IN(I_X); }
    else if (kind == 1) { g = pg8::Gemm{(const bf16*)(ws + WS_H), (const bf16*)(ws + WS_WPOOL) + (size_t)li * 4 * 512 * 512, M, DM, 512, DM, 1}; E.pscale = ARG_IN(I_PSCALE) + (size_t)li * DM; }
    else g = pg8::Gemm{(const bf16*)(ws + WS_ACT), (const bf16*)(ws + WS_WDOWN) + (size_t)l * DM * DFF, M, DM, DFF, DFF, 0};
    pg8::StaticOrder S; S.init(M, DM, G, bid);
    pg8::gemm_phase<pg8::EpiResid, pg8::StaticOrder, false, true>(lds, g, S, E, tid);
}

#ifndef EN_MASK
#define EN_MASK 0xffff
#endif
#define EN(b) ((EN_MASK >> (b)) & 1)
constexpr int NPHASES = 2 + DEPTH * 8 + 1;
__global__ void __launch_bounds__(NWAVES * 64, 2) fwd_kernel(Args args) {
    extern __shared__ __attribute__((aligned(16))) unsigned char lds_raw[];
    LAS unsigned char* lds = (LAS unsigned char*)lds_raw;
    volatile LAS unsigned* MISC = (volatile LAS unsigned*)(lds + MISC_OFF);
    if (threadIdx.x < 32) MISC[threadIdx.x] = 0u;
    __syncthreads();
    if (MK_N_LAUNCHES == 1) (void)xcd_barrier_post((unsigned*)(args.ws + WS_CTL) + CW_BAR, MISC + 8);
#define PH_LO() ((&args.ph_lo)[opaque_zero()])
#define PH_HI() ((&args.ph_hi)[opaque_zero()])
#define IN(k) (PH_LO() <= (k) && (k) < PH_HI())
#define SEAM(k) do { if (IN(k) && IN((k) + 1)) { XcdBarrier bb_; bb_.bar = (unsigned*)((&args.ws)[opaque_zero()] + WS_CTL) + CW_BAR; bb_.x = xb_xcc_id(); \
        bb_.st = (volatile LAS unsigned*)(lds + MISC_OFF) + 8; xcd_barrier(bb_); } } while (0)

    if (EN(0) && IN(0)) p0_prologue(args, lds);
    SEAM(0);
    if (EN(1) && IN(1)) p0b_modreduce(args);
    SEAM(1);

    for (int l = 0; l < DEPTH; ++l) {
        const int pb = 2 + l * 8; const bool attn = (l & 1) == 0;
        if (EN(2) && IN(pb + 0)) { if (attn) norm_phase<0>(args, lds, l); else norm_phase<1>(args, lds, l); }
        SEAM(pb + 0);
        if (EN(3) && IN(pb + 1)) { if (attn) gemm_bf16_phase<0>(args, lds, l); else pooldiff_phase(args, l); }
        SEAM(pb + 1);
        if (EN(4) && IN(pb + 2)) { if (attn) attention_phase(args, lds, l >> 1); }
        if (attn) SEAM(pb + 2);
        if (EN(5) && IN(pb + 3)) gemm_resid_phase(args, lds, l, attn ? 0 : 1);
        SEAM(pb + 3);
        if (EN(6) && IN(pb + 4)) norm_phase<2>(args, lds, l);
        SEAM(pb + 4);
        if (EN(7) && IN(pb + 5)) gemm_bf16_phase<1>(args, lds, l);
        SEAM(pb + 5);
        if (EN(8) && IN(pb + 6)) convgate_phase(args, l);
        SEAM(pb + 6);
        if (EN(9) && IN(pb + 7)) gemm_resid_phase(args, lds, l, 2);
        SEAM(pb + 7);
    }
    if (EN(10) && IN(NPHASES - 1)) norm_phase<3>(args, lds, 0);
#undef IN
#undef SEAM
}

extern "C" void kernel_launch(void* const* d_in, const int* in_sizes, int n_in, void* d_out, int out_size, void* d_ws, size_t ws_size, hipStream_t stream) {
    static int grid = 0;
    if (grid == 0) {
        if (n_in != 15 || in_sizes[0] != M * DM || out_size != M * DM || ws_size < WS_END) { fprintf(stderr, "kernel_launch: unexpected shapes (n_in %d, in0 %d, out %d, ws %zu)\n", n_in, n_in > 0 ? in_sizes[0] : -1, out_size, ws_size); grid = -1; return; }
        int dev = 0, cus = 0, per_cu = 0;
        if (hipGetDevice(&dev) != hipSuccess || hipDeviceGetAttribute(&cus, hipDeviceAttributeMultiprocessorCount, dev) != hipSuccess) { grid = -1; return; }
        if (hipFuncSetAttribute((const void*)fwd_kernel, hipFuncAttributeMaxDynamicSharedMemorySize, LDS_BYTES) != hipSuccess) { fprintf(stderr, "kernel_launch: hipFuncSetAttribute failed\n"); grid = -1; return; }
        if (hipOccupancyMaxActiveBlocksPerMultiprocessor(&per_cu, (const void*)fwd_kernel, NWAVES * 64, LDS_BYTES) != hipSuccess || per_cu < 1) { fprintf(stderr, "kernel_launch: occupancy query says %d\n", per_cu); }
        (void)hipGetLastError();
        grid = cus;
    }
    if (grid < 0) return;
    (void)hipMemsetAsync((char*)d_ws + WS_CTL, 0, CTL_ZERO_BYTES, stream);
    Args a{};
    for (int i = 0; i < 15; ++i) a.in[i] = (const float*)d_in[i];
    a.out = (float*)d_out; a.ws = (unsigned char*)d_ws;
#if MK_N_LAUNCHES == 1
    a.ph_lo = 0; a.ph_hi = NPHASES;
    hipLaunchKernelGGL(fwd_kernel, dim3(grid), dim3(NWAVES * 64), LDS_BYTES, stream, a);
#else
    for (int p = 0; p < NPHASES; ++p) { a.ph_lo = p; a.ph_hi = p + 1; hipLaunchKernelGGL(fwd_kernel, dim3(grid), dim3(NWAVES * 64), LDS_BYTES, stream, a); }
#endif
}
```

```cpp
#include <hip/hip_runtime.h>
#include <cstdio>
#include <cstdint>

#ifndef MK_N_LAUNCHES
#define MK_N_LAUNCHES 1
#endif

#ifndef PROBE_SKIP_EPI
#define PROBE_SKIP_EPI 0
#endif
#ifndef PROBE_MASK
#define PROBE_MASK 0
#endif
constexpr int BATCH = 4, SEQ = 2048, DM = 2048, DEPTH = 4, NH = 16, HD = 128, NSB = 8, NFX = 8;
constexpr int M = BATCH * SEQ;
constexpr int DFF = 5632, F2 = 2 * DFF;
constexpr int NQKV = 3 * DM;
constexpr int NIN = NQKV + NFX;
constexpr int NMOD = 6 * DM;
constexpr int PADE = 64;
constexpr int LDH = DM + PADE;
constexpr int LDU = F2 + PADE, LDACT = DFF + PADE;
constexpr int LDW = DM + PADE, LDWD = DFF + PADE, LDWP = 512 + PADE;
constexpr float EPS = 1e-6f;
constexpr float LOG2E = 1.4426950408889634f;
constexpr float ATT_SCALE = 0.08838834764831845f;
constexpr float SB_EXIT = 1e-24f;

namespace pg8 {
#define PG8_LAS __attribute__((address_space(3)))
typedef unsigned short bf16_t;
typedef short bf16x8 __attribute__((ext_vector_type(8)));
typedef float f32x4 __attribute__((ext_vector_type(4)));
typedef unsigned u32x4 __attribute__((ext_vector_type(4)));
constexpr int BM = 256, BK = 64, HALF = 128, HTB = HALF * BK * 2, STAGE_BYTES = 8 * HTB, NXCD = 8, WGM = 8;

__host__ __device__ __forceinline__ int lds_byte(int r, int c) { const int st = (r >> 4) * 2 + (c >> 5), rr = r & 15, cc = c & 31, ob = rr * 64 + cc * 2; return st * 1024 + (ob ^ (((ob >> 9) & 1) << 5)); }
__host__ __device__ __forceinline__ void stage_rc(int b, int& R, int& C) { const int st = b / 1024, sb = b % 1024, swz = sb ^ (((sb >> 9) & 1) << 5); R = (st >> 1) * 16 + swz / 64; C = (st & 1) * 32 + (swz % 64) / 2; }
__host__ __device__ __forceinline__ int perm32(int rho) { const int n = rho >> 4, i = rho & 15; return 8 * (i >> 2) + 4 * n + (i & 3); }

struct Unit { int pm, pn; };
struct Gemm { const bf16_t* A; const bf16_t* Bt; int M, N, K, lda, ldb, grouped, b_unit_rows, b_half_rows; };

struct StaticOrder {
    int nM, nN, nwg, G, c;
    __host__ __device__ void init(int M_, int N_, int G_, int c_) { nM = M_ / BM; nN = N_ / BM; nwg = nM * nN; G = G_; c = c_; }
    __host__ __device__ bool next(int i, Unit& u) const {
        const long L = (long)i * G + c; if (L >= nwg) return false;
        int wgid = (int)L; { const int q = nwg / NXCD, r = nwg % NXCD, xcd = wgid % NXCD, off = wgid / NXCD; wgid = (xcd < r ? xcd * (q + 1) : r * (q + 1) + (xcd - r) * q) + off; }
        const int nig = WGM * nN, gid = wgid / nig, fm = gid * WGM, gsz = (nM - fm) < WGM ? (nM - fm) : WGM;
        u.pm = fm + ((wgid % nig) % gsz); u.pn = (wgid % nig) / gsz; return true;
    }
    __device__ __forceinline__ void a_ready(const Unit&) const {}
    __device__ __forceinline__ void done(const Unit&) const {}
};

__device__ __forceinline__ unsigned cvt_pk_bf16(float lo, float hi) { unsigned r; asm volatile("v_cvt_pk_bf16_f32 %0, %1, %2" : "=v"(r) : "v"(lo), "v"(hi)); return r; }

struct EpiBf16 {
    static constexpr bool PERM = true, AFTER_DRAIN = false;
    bf16_t* O; int ldc; int split_cols; size_t split_stride; int skip;
    __device__ __forceinline__ void operator()(const f32x4 (&acc)[2][2][4][2], const Unit& u, int wr, int wc, int fr, int fq) const {
        if (skip) return;
        const int row0 = u.pm * BM + wr * 64 + fr; int colt = u.pn * BM; bf16_t* base = O;
        if (split_cols) { const int t = colt / split_cols; base += (size_t)t * split_stride; colt -= t * split_cols; }
        const int col0 = colt + wc * 32 + 8 * fq;
#pragma unroll
        for (int ai = 0; ai < 2; ++ai)
#pragma unroll
            for (int m = 0; m < 4; ++m) { bf16_t* rowp = base + (size_t)(row0 + ai * HALF + m * 16) * ldc + col0;
#pragma unroll
                for (int bj = 0; bj < 2; ++bj) { const f32x4 v0 = acc[ai][bj][m][0], v1 = acc[ai][bj][m][1];
                    u32x4 w; w.x = cvt_pk_bf16(v0[0], v0[1]); w.y = cvt_pk_bf16(v0[2], v0[3]); w.z = cvt_pk_bf16(v1[0], v1[1]); w.w = cvt_pk_bf16(v1[2], v1[3]);
                    *(u32x4*)(rowp + bj * HALF) = w; } }
    }
};
struct EpiResid {
    static constexpr bool PERM = false, AFTER_DRAIN = false;
    const float* xin; float* xout; const float* gate; const float* pscale;
    __device__ __forceinline__ void operator()(const f32x4 (&acc)[2][2][4][2], const Unit& u, int wr, int wc, int fr, int fq) const {
        const int row0 = u.pm * BM + wr * 64 + fr, col0 = u.pn * BM + wc * 32 + 4 * fq; const int b = u.pm >> 3;
        f32x4 gv[2][2];
#pragma unroll
        for (int bj = 0; bj < 2; ++bj)
#pragma unroll
            for (int n = 0; n < 2; ++n) { gv[bj][n] = *(const f32x4*)(gate + (size_t)b * NMOD + col0 + bj * HALF + n * 16);
                if (pscale) gv[bj][n] = gv[bj][n] * *(const f32x4*)(pscale + col0 + bj * HALF + n * 16); }
#pragma unroll
        for (int ai = 0; ai < 2; ++ai)
#pragma unroll
            for (int m = 0; m < 4; ++m) { const size_t off = (size_t)(row0 + ai * HALF + m * 16) * DM + col0;
#pragma unroll
                for (int bj = 0; bj < 2; ++bj)
#pragma unroll
                    for (int n = 0; n < 2; ++n) { const f32x4 xv = *(const f32x4*)(xin + off + bj * HALF + n * 16);
                        *(f32x4*)(xout + off + bj * HALF + n * 16) = xv + gv[bj][n] * acc[ai][bj][m][n]; }
                asm volatile("" ::: "memory"); }
    }
};


template <int CTRL> __device__ __forceinline__ float dpp_keep(float old, float src) {
    return __builtin_bit_cast(float, __builtin_amdgcn_update_dpp(__builtin_bit_cast(int, old), __builtin_bit_cast(int, src), CTRL, 0xf, 0xf, false)); }
template <int CTRL> __device__ __forceinline__ float dpp_zero(float src) {
    return __builtin_bit_cast(float, __builtin_amdgcn_update_dpp(0, __builtin_bit_cast(int, src), CTRL, 0xf, 0xf, true)); }
struct EpiConvGate {
    static constexpr bool PERM = true, AFTER_DRAIN = false;
    bf16_t* ACT; int ldact; const float* cw; const float* cb; float* edge; PG8_LAS float* hal; int f2, dff;
    __device__ __forceinline__ void operator()(const f32x4 (&acc)[2][2][4][2], const Unit& u, int wr, int wc, int fr, int fq) const {
        const int cl = wc * 32 + 8 * fq;
        if (fr >= 14) {
#pragma unroll
            for (int ai = 0; ai < 2; ++ai)
#pragma unroll
                for (int bj = 0; bj < 2; ++bj)
#pragma unroll
                    for (int n = 0; n < 2; ++n) *(PG8_LAS f32x4*)(hal + ((((ai * 2 + wr) * 2 + (fr - 14)) * 2 + bj) * 128 + cl + 4 * n)) = acc[ai][bj][3][n];
        }
        if (wr == 0 && fr < 2) {
#pragma unroll
            for (int bj = 0; bj < 2; ++bj)
#pragma unroll
                for (int n = 0; n < 2; ++n) *(f32x4*)(edge + (((size_t)u.pm * 4 + fr) * 2 + bj) * dff + u.pn * 128 + cl + 4 * n) = acc[0][bj][0][n];
        }
        if (wr == 1 && fr >= 14) {
#pragma unroll
            for (int bj = 0; bj < 2; ++bj)
#pragma unroll
                for (int n = 0; n < 2; ++n) *(f32x4*)(edge + (((size_t)u.pm * 4 + 2 + (fr - 14)) * 2 + bj) * dff + u.pn * 128 + cl + 4 * n) = acc[1][bj][3][n];
        }
        asm volatile("s_waitcnt lgkmcnt(0)" ::: "memory"); __builtin_amdgcn_s_barrier(); asm volatile("" ::: "memory");
        const bool bstart = (u.pm & 7) == 0;
#pragma unroll
        for (int n = 0; n < 2; ++n) {
            const int col = u.pn * 128 + cl + 4 * n;
            const f32x4 w0a = *(const f32x4*)(cw + col), w1a = *(const f32x4*)(cw + f2 + col), w2a = *(const f32x4*)(cw + 2 * f2 + col), ba = *(const f32x4*)(cb + col);
            const f32x4 w0g = *(const f32x4*)(cw + dff + col), w1g = *(const f32x4*)(cw + f2 + dff + col), w2g = *(const f32x4*)(cw + 2 * f2 + dff + col), bg = *(const f32x4*)(cb + dff + col);
#pragma unroll
            for (int ai = 0; ai < 2; ++ai)
#pragma unroll
                for (int m = 0; m < 4; ++m) {
                    f32x4 pa, pg;
                    if (m > 0) { pa = acc[ai][0][m - 1][n]; pg = acc[ai][1][m - 1][n]; }
                    else if (wr == 1 || ai == 1) { const int sa = (wr == 1) ? ai : 0, sw = (wr == 1) ? 0 : 1;
                        const PG8_LAS float* hp = hal + ((((sa * 2 + sw) * 2 + (fr & 1)) * 2) * 128 + cl + 4 * n);
                        pa = *(const PG8_LAS f32x4*)hp; pg = *(const PG8_LAS f32x4*)(hp + 128); }
                    else { pa = (f32x4){0.f, 0.f, 0.f, 0.f}; pg = pa; }
                    const f32x4 ca = acc[ai][0][m][n], cg = acc[ai][1][m][n];
                    float o[4];
#pragma unroll
                    for (int e = 0; e < 4; ++e) {
                        const float a1 = dpp_keep<0x10F>(dpp_zero<0x111>(ca[e]), pa[e]), a2 = dpp_keep<0x10E>(dpp_zero<0x112>(ca[e]), pa[e]);
                        const float g1 = dpp_keep<0x10F>(dpp_zero<0x111>(cg[e]), pg[e]), g2 = dpp_keep<0x10E>(dpp_zero<0x112>(cg[e]), pg[e]);
                        const float ya = ba[e] + w0a[e] * a2 + w1a[e] * a1 + w2a[e] * ca[e];
                        const float yg = bg[e] + w0g[e] * g2 + w1g[e] * g1 + w2g[e] * cg[e];
                        o[e] = ya * yg * __builtin_amdgcn_rcpf(1.0f + __expf(-yg)); }
                    const bool skip = (ai == 0) && (m == 0) && (wr == 0) && (fr < 2) && !bstart;
                    if (!skip) { typedef unsigned u32x2 __attribute__((ext_vector_type(2))); u32x2 w; w.x = cvt_pk_bf16(o[0], o[1]); w.y = cvt_pk_bf16(o[2], o[3]);
                        *(u32x2*)(ACT + (size_t)(u.pm * BM + ai * HALF + wr * 64 + m * 16 + fr) * ldact + col) = w; }
                }
        }
    }
};

template <class Epi, class Sched, bool ALIGN_EPI = false, bool SP2 = false>
__device__ __forceinline__ void gemm_phase(PG8_LAS unsigned char* lds, const Gemm g, const Sched& S, const Epi& E, const int tid) {
    const int wid = __builtin_amdgcn_readfirstlane(tid >> 6), lane = tid & 63, wr = wid >> 2, wc = wid & 3, fr = lane & 15, fq = lane >> 4;
    const int K = g.K, nt = K / BK, lda = g.lda, ldb = g.ldb;
    unsigned voffA[2], voffB[2];
#pragma unroll
    for (int i = 0; i < 2; ++i) { int R, C; stage_rc(tid * 16 + i * 8192, R, C); const int Rb = Epi::PERM ? ((R & ~31) + perm32(R & 31)) : R;
        voffA[i] = (unsigned)(R * lda + C) * 2u; voffB[i] = (unsigned)(Rb * ldb + C) * 2u; }
    const size_t kstep = (size_t)(BK * 2);
    const size_t hstepA = (size_t)HALF * lda * 2, hstepB = (size_t)g.b_half_rows * ldb * 2;
    const size_t tstepA = 2 * hstepA, tstepB = (size_t)g.b_unit_rows * ldb * 2;
    const unsigned ldsw = (unsigned)wid * 1024u;
    const int aoff = lds_byte(wr * 64 + fr, fq * 8), boff = lds_byte(wc * 32 + fr, fq * 8);
#define PG8_UA(u) ((const char*)g.A + (size_t)(u).pm * tstepA + (g.grouped ? (size_t)((u).pn >> 1) * (size_t)K * 2 : (size_t)0))
#define PG8_UB(u) ((const char*)g.Bt + (size_t)(u).pn * tstepB)
#define PG8_SA(b, h) (((b) * 2 + (h)) * HTB)
#define PG8_SB(b, h) ((4 + (b) * 2 + (h)) * HTB)
#define PG8_STAGE(bufoff, gbase, voff) do { _Pragma("unroll") for (int _i = 0; _i < 2; ++_i) \
        __builtin_amdgcn_global_load_lds((const unsigned*)((const char*)(gbase) + (voff)[_i]), (PG8_LAS unsigned*)(lds + (bufoff) + ldsw + _i * 8192), 16, 0, 0); } while (0)
#define PG8_LDA(dst, b, h) do { _Pragma("unroll") for (int m = 0; m < 4; ++m) _Pragma("unroll") for (int k = 0; k < 2; ++k) dst[m][k] = *(const PG8_LAS bf16x8*)(lds + PG8_SA(b, h) + aoff + m * 2048 + k * 1024); } while (0)
#define PG8_LDB(dst, b, h) do { _Pragma("unroll") for (int n = 0; n < 2; ++n) _Pragma("unroll") for (int k = 0; k < 2; ++k) dst[n][k] = *(const PG8_LAS bf16x8*)(lds + PG8_SB(b, h) + boff + n * 2048 + k * 1024); } while (0)
#define PG8_MMA(ai, bj, At, Bt) do { __builtin_amdgcn_s_setprio(1); _Pragma("unroll") for (int m = 0; m < 4; ++m) _Pragma("unroll") for (int n = 0; n < 2; ++n) _Pragma("unroll") for (int k = 0; k < 2; ++k) \
        acc[ai][bj][m][n] = __builtin_amdgcn_mfma_f32_16x16x32_bf16(Bt[n][k], At[m][k], acc[ai][bj][m][n], 0, 0, 0); __builtin_amdgcn_s_setprio(0); } while (0)
#define PG8_WAIT_V(n) asm volatile("s_waitcnt vmcnt(" #n ")" ::: "memory")
#define PG8_WAIT_L(n) asm volatile("s_waitcnt lgkmcnt(" #n ")" ::: "memory")
#define PG8_BAR __builtin_amdgcn_s_barrier()
#define PG8_SCHED __builtin_amdgcn_sched_barrier(0)
    Unit cur, nxt; int ui = 0;
    if (!S.next(0, cur)) return;
    f32x4 acc[2][2][4][2];
#pragma unroll
    for (int a = 0; a < 2; ++a)
#pragma unroll
        for (int b = 0; b < 2; ++b)
#pragma unroll
            for (int m = 0; m < 4; ++m)
#pragma unroll
                for (int n = 0; n < 2; ++n) acc[a][b][m][n] = (f32x4){0.f, 0.f, 0.f, 0.f};
    bf16x8 At[4][2], B0[2][2], B1[2][2];
    const char* cA = PG8_UA(cur); const char* cB = PG8_UB(cur);
    S.a_ready(cur);
    if constexpr (SP2) {
        PG8_STAGE(PG8_SB(0, 0), cB, voffB); PG8_STAGE(PG8_SB(0, 1), cB + hstepB, voffB); PG8_STAGE(PG8_SA(0, 0), cA, voffA); PG8_STAGE(PG8_SA(0, 1), cA + hstepA, voffA);
        if (wr == 1) PG8_BAR;
        PG8_WAIT_V(2); PG8_BAR;
        PG8_STAGE(PG8_SB(1, 0), cB + kstep, voffB); PG8_STAGE(PG8_SA(1, 0), cA + kstep, voffA); PG8_STAGE(PG8_SB(1, 1), cB + hstepB + kstep, voffB);
        PG8_WAIT_V(6); PG8_BAR;
    } else {
        PG8_STAGE(PG8_SB(0, 0), cB, voffB); PG8_STAGE(PG8_SA(0, 0), cA, voffA); PG8_STAGE(PG8_SB(0, 1), cB + hstepB, voffB); PG8_STAGE(PG8_SA(0, 1), cA + hstepA, voffA);
        if (wr == 1) PG8_BAR;
        PG8_WAIT_V(4); PG8_BAR;
        PG8_STAGE(PG8_SB(1, 0), cB + kstep, voffB); PG8_STAGE(PG8_SA(1, 0), cA + kstep, voffA); PG8_STAGE(PG8_SB(1, 1), cB + hstepB + kstep, voffB);
        PG8_WAIT_V(6); PG8_BAR;
    }
    for (;;) {
        const bool has_next = S.next(ui + 1, nxt);
        const char* nA = has_next ? PG8_UA(nxt) : cA; const char* nB = has_next ? PG8_UB(nxt) : cB;
        for (int t = 0; t < nt; t += 2) {
            const bool last = (t == nt - 2);
            const char* a1 = cA + (size_t)(t + 1) * kstep;
            const char* a2 = last ? nA : cA + (size_t)(t + 2) * kstep; const char* b2 = last ? nB : cB + (size_t)(t + 2) * kstep;
            const char* a3 = a2 + kstep; const char* b3 = b2 + kstep;
            if (last && has_next) S.a_ready(nxt);
            if constexpr (SP2) {
            PG8_LDB(B0, 0, 0); PG8_LDB(B1, 0, 1); PG8_SCHED; PG8_LDA(At, 0, 0); PG8_STAGE(PG8_SA(1, 1), a1 + hstepA, voffA);
            PG8_WAIT_V(8); PG8_WAIT_L(0); PG8_BAR; PG8_MMA(0, 0, At, B0); PG8_MMA(0, 1, At, B1); PG8_BAR; PG8_SCHED;
            PG8_LDA(At, 0, 1); PG8_STAGE(PG8_SB(0, 0), b2, voffB); PG8_STAGE(PG8_SB(0, 1), b2 + hstepB, voffB); PG8_STAGE(PG8_SA(0, 0), a2, voffA);
            PG8_WAIT_V(8); PG8_WAIT_L(0); PG8_BAR; PG8_MMA(1, 0, At, B0); PG8_MMA(1, 1, At, B1); PG8_BAR; PG8_SCHED;
            PG8_LDB(B0, 1, 0); PG8_LDB(B1, 1, 1); PG8_SCHED; PG8_LDA(At, 1, 0); PG8_STAGE(PG8_SA(0, 1), a2 + hstepA, voffA);
            PG8_WAIT_V(8); PG8_WAIT_L(0); PG8_BAR; PG8_MMA(0, 0, At, B0); PG8_MMA(0, 1, At, B1); PG8_BAR; PG8_SCHED;
            PG8_LDA(At, 1, 1); PG8_STAGE(PG8_SB(1, 0), b3, voffB); PG8_STAGE(PG8_SB(1, 1), b3 + hstepB, voffB); PG8_STAGE(PG8_SA(1, 0), a3, voffA);
            PG8_WAIT_V(8); PG8_WAIT_L(0); PG8_BAR; PG8_MMA(1, 0, At, B0); PG8_MMA(1, 1, At, B1); PG8_BAR; PG8_SCHED;
            } else {
            PG8_LDB(B0, 0, 0); PG8_SCHED; PG8_LDA(At, 0, 0); PG8_STAGE(PG8_SA(1, 1), a1 + hstepA, voffA);
            PG8_WAIT_L(8); PG8_BAR; PG8_WAIT_L(0); PG8_MMA(0, 0, At, B0); PG8_BAR; PG8_SCHED;
            PG8_LDB(B1, 0, 1); PG8_STAGE(PG8_SB(0, 0), b2, voffB);
            PG8_BAR; PG8_WAIT_L(0); PG8_MMA(0, 1, At, B1); PG8_BAR;
            PG8_LDA(At, 0, 1); PG8_STAGE(PG8_SA(0, 0), a2, voffA);
            PG8_BAR; PG8_WAIT_L(0); PG8_MMA(1, 0, At, B0); PG8_BAR; PG8_SCHED;
            PG8_STAGE(PG8_SB(0, 1), b2 + hstepB, voffB);
            PG8_WAIT_V(6); PG8_BAR; PG8_MMA(1, 1, At, B1); PG8_BAR;
            PG8_LDB(B0, 1, 0); PG8_SCHED; PG8_LDA(At, 1, 0); PG8_STAGE(PG8_SA(0, 1), a2 + hstepA, voffA);
            PG8_WAIT_L(8); PG8_BAR; PG8_WAIT_L(0); PG8_MMA(0, 0, At, B0); PG8_BAR; PG8_SCHED;
            PG8_LDB(B1, 1, 1); PG8_STAGE(PG8_SB(1, 0), b3, voffB);
            PG8_BAR; PG8_WAIT_L(0); PG8_MMA(0, 1, At, B1); PG8_BAR;
            PG8_LDA(At, 1, 1); PG8_STAGE(PG8_SA(1, 0), a3, voffA);
            PG8_BAR; PG8_WAIT_L(0); PG8_MMA(1, 0, At, B0); PG8_BAR; PG8_SCHED;
            PG8_STAGE(PG8_SB(1, 1), b3 + hstepB, voffB);
            PG8_WAIT_V(6); PG8_BAR; PG8_MMA(1, 1, At, B1); PG8_BAR;
            }
        }
        if constexpr (ALIGN_EPI) { if (wr == 0) PG8_BAR; }
        if constexpr (!Epi::AFTER_DRAIN) { E(acc, cur, wr, wc, fr, fq); S.done(cur); }
        if (!has_next) break;
#pragma unroll
        for (int a = 0; a < 2; ++a)
#pragma unroll
            for (int b = 0; b < 2; ++b)
#pragma unroll
                for (int m = 0; m < 4; ++m)
#pragma unroll
                    for (int n = 0; n < 2; ++n) acc[a][b][m][n] = (f32x4){0.f, 0.f, 0.f, 0.f};
        cur = nxt; cA = nA; cB = nB; ++ui;
        if constexpr (ALIGN_EPI) { if (wr == 1) PG8_BAR; }
    }
    PG8_WAIT_V(0);
    if constexpr (!ALIGN_EPI) { if (wr == 0) PG8_BAR; }
    PG8_BAR;
#undef PG8_UA
#undef PG8_UB
#undef PG8_SA
#undef PG8_SB
#undef PG8_STAGE
#undef PG8_LDA
#undef PG8_LDB
#undef PG8_MMA
#undef PG8_WAIT_V
#undef PG8_WAIT_L
#undef PG8_BAR
#undef PG8_SCHED
}
}

#define GAS __attribute__((address_space(1)))
#define LAS __attribute__((address_space(3)))
typedef unsigned short bf16;
typedef unsigned v4u __attribute__((ext_vector_type(4)));
typedef unsigned v2u __attribute__((ext_vector_type(2)));
typedef float f32x4 __attribute__((ext_vector_type(4)));
typedef float f32x16 __attribute__((ext_vector_type(16)));
typedef short bf16x8 __attribute__((ext_vector_type(8)));
typedef short s16x4 __attribute__((ext_vector_type(4)));
typedef GAS unsigned gu32;
#define RLX_AGENT __ATOMIC_RELAXED, __HIP_MEMORY_SCOPE_AGENT
#define LDS_WAIT() asm volatile("s_waitcnt lgkmcnt(0)" ::: "memory")
#define VM_WAIT() asm volatile("s_waitcnt vmcnt(0)" ::: "memory")
__device__ __forceinline__ unsigned pk2(float lo, float hi) { unsigned r; asm volatile("v_cvt_pk_bf16_f32 %0, %1, %2" : "=v"(r) : "v"(lo), "v"(hi)); return r; }
__device__ __forceinline__ float bflo(unsigned w) { return __uint_as_float(w << 16); }
__device__ __forceinline__ float bfhi(unsigned w) { return __uint_as_float(w & 0xffff0000u); }

#define XB_TMO      128
#define XB_XCNT(j)  (256  + 64 * (j))
#define XB_XSUB(j)  (1280 + 64 * (j))
#define XB_XGEN(j)  (2304 + 64 * (j))
#define XB_TOP      3328
#define XB_TOPGEN   3392
#define XCD_BAR_WORDS 3456
#define XB_SPIN_CAP (1u << 18)
__device__ __forceinline__ unsigned xb_ld(unsigned* p)              { return __hip_atomic_load(p, __ATOMIC_RELAXED, __HIP_MEMORY_SCOPE_AGENT); }
__device__ __forceinline__ unsigned xb_add(unsigned* p, unsigned v) { return __hip_atomic_fetch_add(p, v, __ATOMIC_RELAXED, __HIP_MEMORY_SCOPE_AGENT); }
__device__ __forceinline__ unsigned xb_xcc_id() { return (unsigned)__builtin_amdgcn_s_getreg((3 << 11) | 20) & 0xFu; }
#define XB_SPIN(cond, bar) do { unsigned _sp = 0; while (cond) { __builtin_amdgcn_s_sleep(1); \
    if ((++_sp & 255u) == 0u) { if (xb_ld(&(bar)[XB_TMO])) break; if (_sp > XB_SPIN_CAP) { atomicAdd(&(bar)[XB_TMO], 1u); break; } } } } while (0)
struct XcdBarrier { unsigned* bar; unsigned x; volatile LAS unsigned* st; };
__device__ __forceinline__ XcdBarrier xcd_barrier_post(unsigned* bar, volatile LAS unsigned* st) {
    XcdBarrier b; b.bar = bar; b.x = xb_xcc_id(); b.st = st;
    if (threadIdx.x == 0) (void)xb_add(&bar[XB_XCNT(b.x)], 1u);
    return b;
}
__device__ __forceinline__ void xcd_barrier_complete(unsigned* bar, unsigned x, unsigned& nloc, unsigned& nx) {
    const unsigned G = gridDim.x * gridDim.y * gridDim.z;
    unsigned sum, cnt, mine, sp = 0u;
    for (;;) {
        sum = 0u; cnt = 0u; mine = 0u;
#pragma unroll
        for (unsigned j = 0; j < 16; ++j) { const unsigned c = xb_ld(&bar[XB_XCNT(j)]); sum += c; cnt += (c > 0u) ? 1u : 0u; mine = (j == x) ? c : mine; }
        if (sum == G) break;
        __builtin_amdgcn_s_sleep(1);
        if ((++sp & 255u) == 0u) { if (xb_ld(&bar[XB_TMO])) break; if (sp > XB_SPIN_CAP) { atomicAdd(&bar[XB_TMO], 1u); break; } }
    }
    nloc = mine > 0u ? mine : 1u; nx = cnt > 0u ? cnt : 1u;
}
__device__ __forceinline__ void xcd_barrier(const XcdBarrier& b) {
    asm volatile("s_waitcnt vmcnt(0)" ::: "memory");
    __syncthreads();
    if (threadIdx.x == 0) {
        unsigned* bar = b.bar;
        __builtin_amdgcn_s_waitcnt(0);
        unsigned nloc = b.st[0], nx = b.st[1];
        if (nloc == 0u) { xcd_barrier_complete(bar, b.x, nloc, nx); b.st[0] = nloc; b.st[1] = nx; }
        const unsigned old = xb_add(&bar[XB_XSUB(b.x)], 1u);
        const unsigned gen = old / nloc;
        if (old + 1u == (gen + 1u) * nloc) {
            __builtin_amdgcn_fence(__ATOMIC_RELEASE, "agent");
            asm volatile("s_waitcnt vmcnt(0)" ::: "memory");
            const unsigned og = xb_add(&bar[XB_TOP], 1u);
            const unsigned tg = og / nx;
            if (og + 1u == (tg + 1u) * nx) xb_add(&bar[XB_TOPGEN], 1u);
            else XB_SPIN(xb_ld(&bar[XB_TOPGEN]) == tg, bar);
            __builtin_amdgcn_fence(__ATOMIC_ACQUIRE, "agent");
            xb_add(&bar[XB_XGEN(b.x)], 1u);
            asm volatile("s_waitcnt vmcnt(0)" ::: "memory");
        } else {
            XB_SPIN(xb_ld(&bar[XB_XGEN(b.x)]) == gen, bar);
            __builtin_amdgcn_fence(__ATOMIC_ACQUIRE, "agent");
            asm volatile("s_waitcnt vmcnt(0)" ::: "memory");
        }
    }
    __syncthreads();
}

constexpr size_t MiB = 1u << 20;
constexpr size_t WS_CTL = 0, CTL_ZERO_BYTES = 1 * MiB;
constexpr size_t WS_MOD = 1 * MiB;
constexpr size_t WS_RSTD = 2 * MiB;
constexpr size_t WS_FLOG = 3 * MiB;
constexpr size_t WS_MODP = 4 * MiB;
constexpr size_t WS_WIN = 32 * MiB;
constexpr size_t SZ_WIN = 25 * MiB, SZ_WOUT = 17 * MiB / 2, SZ_WPOOL = 5 * MiB / 2, SZ_WUP = 46 * MiB, SZ_WDOWN = 45 * MiB / 2;
constexpr size_t WS_WOUT = 82 * MiB;
constexpr size_t WS_WPOOL = 99 * MiB;
constexpr size_t WS_WUP = 104 * MiB;
constexpr size_t WS_WDOWN = 288 * MiB;
constexpr size_t WS_H = 378 * MiB;
constexpr size_t WS_Q = 411 * MiB, WS_K = 444 * MiB, WS_V = 477 * MiB;
constexpr size_t WS_AO = 510 * MiB;
constexpr size_t WS_U = 543 * MiB;
constexpr size_t WS_ACT = 720 * MiB;
constexpr size_t WS_EDGE = 809 * MiB;
constexpr size_t WS_END = 815 * MiB;
static_assert((size_t)NQKV * LDW * 2 <= SZ_WIN && (size_t)DM * LDW * 2 <= SZ_WOUT && (size_t)2048 * LDWP * 2 <= SZ_WPOOL && (size_t)F2 * LDW * 2 <= SZ_WUP && (size_t)DM * LDWD * 2 <= SZ_WDOWN && (size_t)M * LDH * 2 <= 33 * MiB && (size_t)M * LDU * 2 <= 177 * MiB && (size_t)M * LDACT * 2 <= 89 * MiB, "ws map");
constexpr int CW_BAR = 4096;
constexpr int CW_QUEUE = 16384;

constexpr int SCR_BYTES = 133120;
constexpr int MISC_OFF = SCR_BYTES;
constexpr int HALO_OFF = MISC_OFF + 1024;
constexpr int LDS_BYTES = 147456;
constexpr int NWAVES = 8;


struct Args { const float* in[15]; float* out; unsigned char* ws; int ph_lo, ph_hi, probe, pad; };
enum { I_X = 0, I_C, I_WMOD, I_BMOD, I_GAIN, I_WIN, I_BF, I_WOUT, I_WPOOL, I_PSCALE, I_WUP, I_CONVW, I_CONVB, I_WDOWN, I_FGAIN };
__device__ __forceinline__ int opaque_zero() { int z = 0; asm volatile("" : "+s"(z)); return z; }
__device__ __forceinline__ int opaque_v(int v) { asm volatile("" : "+v"(v)); return v; }
__device__ __forceinline__ int opaque_s(int v) { asm volatile("" : "+s"(v)); return v; }
#define ARG_IN(k) (args.in[(k) + zz])
#define ARG_OUT() ((&args.out)[zz])
#define ARG_WS() ((&args.ws)[zz])
#define PHASE_LOCALS const int zz = opaque_zero(); const int wave = opaque_s(wv), tid = opaque_v((int)__builtin_amdgcn_mbcnt_hi(~0u, __builtin_amdgcn_mbcnt_lo(~0u, 0u)) + 64 * wave), bid = opaque_s((int)blockIdx.x), lane = tid & 63, G = gridDim.x; unsigned char* const ws = ARG_WS(); (void)lane; (void)wave; (void)G; (void)ws; (void)bid

__device__ __forceinline__ float wave_sum(float v) {
#pragma unroll
    for (int o = 1; o < 64; o <<= 1) v += __shfl_xor(v, o);
    return v;
}
__device__ __forceinline__ float silu_f(float v) { return v / (1.f + __expf(-v)); }

__device__ __forceinline__ void transpose_tile(const float* W, int ldw, int ldt, bf16* WT, int k0, int n0, LAS float* scr, int lane) {
    const int kq = lane >> 4, nc = (lane & 15) * 4;
    f32x4 v[16];
#pragma unroll
    for (int i = 0; i < 16; ++i) v[i] = *(const GAS f32x4*)(W + (size_t)(k0 + 4 * i + kq) * ldw + n0 + nc);
#pragma unroll
    for (int i = 0; i < 16; ++i) { LAS float* s = scr + (4 * i + kq) * 65 + nc; s[0] = v[i].x; s[1] = v[i].y; s[2] = v[i].z; s[3] = v[i].w; }
    LDS_WAIT(); asm volatile("" ::: "memory");
    const int c = lane & 7, nr = lane >> 3;
#pragma unroll
    for (int j = 0; j < 8; ++j) { const int n = nr + 8 * j; const LAS float* s = scr + (8 * c) * 65 + n;
        v4u o; o.x = pk2(s[0 * 65], s[1 * 65]); o.y = pk2(s[2 * 65], s[3 * 65]); o.z = pk2(s[4 * 65], s[5 * 65]); o.w = pk2(s[6 * 65], s[7 * 65]);
        *(GAS v4u*)(WT + (size_t)(n0 + n) * ldt + k0 + 8 * c) = o; }
    LDS_WAIT(); asm volatile("" ::: "memory");
}
__device__ __forceinline__ void p0_prologue(const Args& args, const int wv, LAS unsigned char* lds) {
    PHASE_LOCALS;
    LAS float* scr = (LAS float*)(lds + wave * 16640);
    const int gw = bid * NWAVES + wave, NGW = G * NWAVES;
    constexpr int MOD_ITEMS = DEPTH * 32 * (NMOD / 256);
    float* modp = (float*)(ws + WS_MODP);
    { const float* c_in = ARG_IN(I_C); const float* w_mod = ARG_IN(I_WMOD);
    for (int it = gw; it < MOD_ITEMS; it += NGW) {
        const int l = it / (32 * 48), rem = it % (32 * 48), kc = rem / 48, nb = rem % 48;
        const int k0 = kc * 64, n = nb * 256 + lane * 4;
        { f32x4 cb;
          cb.x = silu_f(c_in[0 * DM + k0 + lane]); cb.y = silu_f(c_in[1 * DM + k0 + lane]); cb.z = silu_f(c_in[2 * DM + k0 + lane]); cb.w = silu_f(c_in[3 * DM + k0 + lane]);
          *(LAS f32x4*)(scr + 4 * lane) = cb; }
        LDS_WAIT(); asm volatile("" ::: "memory");
        f32x4 acc[4] = {};
        const float* wp = w_mod + ((size_t)l * DM + k0) * NMOD + n;
#pragma unroll 16
        for (int kk = 0; kk < 64; ++kk) {
            const f32x4 w = *(const GAS f32x4*)(wp + (size_t)kk * NMOD);
            const f32x4 s = *(const LAS f32x4*)(scr + 4 * kk);
            acc[0] = acc[0] + w * s.x; acc[1] = acc[1] + w * s.y; acc[2] = acc[2] + w * s.z; acc[3] = acc[3] + w * s.w;
        }
        LDS_WAIT(); asm volatile("" ::: "memory");
#pragma unroll
        for (int b = 0; b < 4; ++b) *(GAS f32x4*)(modp + (((size_t)kc * DEPTH + l) * BATCH + b) * NMOD + n) = acc[b];
    } }
    constexpr int T_IN = (DM / 64) * (NQKV / 64), T_OUT = (DM / 64) * (DM / 64), T_POOL = 8 * 8, T_UP = (DM / 64) * (F2 / 64), T_DOWN = (DFF / 64) * (DM / 64);
    constexpr int E0 = 2 * T_IN, E1 = E0 + 2 * T_OUT, E2 = E1 + 8 * T_POOL, E3 = E2 + 4 * T_UP, T_ALL = E3 + 4 * T_DOWN;
    for (int it = gw; it < T_ALL; it += NGW) {
        const float* W; bf16* WT; int ldw, ldt, N, r;
        if (it < E0)      { const int i = it / T_IN;  r = it % T_IN;  W = ARG_IN(I_WIN) + (size_t)i * DM * NIN;  ldw = NIN; ldt = LDW;  N = NQKV; WT = (bf16*)(ws + WS_WIN + i * SZ_WIN); }
        else if (it < E1) { const int q = it - E0, i = q / T_OUT;  r = q % T_OUT;  W = ARG_IN(I_WOUT) + (size_t)i * DM * DM;  ldw = DM;  ldt = LDW;  N = DM;   WT = (bf16*)(ws + WS_WOUT + i * SZ_WOUT); }
        else if (it < E2) { const int q = it - E1, i = q / T_POOL; r = q % T_POOL; W = ARG_IN(I_WPOOL) + (size_t)i * 512 * 512; ldw = 512; ldt = LDWP; N = 512;  WT = (bf16*)(ws + WS_WPOOL + (i >> 2) * SZ_WPOOL) + (size_t)(i & 3) * 512 * LDWP; }
        else if (it < E3) { const int q = it - E2, i = q / T_UP;   r = q % T_UP;   W = ARG_IN(I_WUP) + (size_t)i * DM * F2;    ldw = F2;  ldt = LDW;  N = F2;   WT = (bf16*)(ws + WS_WUP + i * SZ_WUP); }
        else              { const int q = it - E3, i = q / T_DOWN; r = q % T_DOWN; W = ARG_IN(I_WDOWN) + (size_t)i * DFF * DM; ldw = DM;  ldt = LDWD; N = DM;   WT = (bf16*)(ws + WS_WDOWN + i * SZ_WDOWN); }
        const int nb = N / 64;
        transpose_tile(W, ldw, ldt, WT, (r / nb) * 64, (r % nb) * 64, scr, lane);
    }
}
__device__ __forceinline__ void p0b_modreduce(const Args& args, const int wv) {
    PHASE_LOCALS;
    const float* modp = (const float*)(ws + WS_MODP); float* mod = (float*)(ws + WS_MOD); const float* b_mod = ARG_IN(I_BMOD);
    constexpr int TOT4 = DEPTH * BATCH * NMOD / 4;
    for (int i = bid * 512 + tid; i < TOT4; i += G * 512) {
        const int e = i * 4, l = e / (BATCH * NMOD), n = e % NMOD;
        f32x4 s = *(const GAS f32x4*)(b_mod + (size_t)l * NMOD + n);
#pragma unroll 8
        for (int kc = 0; kc < 32; ++kc) s = s + *(const GAS f32x4*)(modp + (size_t)kc * (DEPTH * BATCH * NMOD) + e);
        *(GAS f32x4*)(mod + e) = s;
    }
}

template <int MODE>
__device__ __forceinline__ void norm_phase(const Args& args, const int wv, LAS unsigned char* lds, int l) {
    PHASE_LOCALS;
    const int li = l >> 1;
    const float* x = (l == 0 && MODE < 2) ? ARG_IN(I_X) : (const float*)ARG_OUT();
    const float* gain = (MODE == 3) ? ARG_IN(I_FGAIN) : ARG_IN(I_GAIN) + (size_t)(l * 2 + (MODE == 2 ? 1 : 0)) * DM;
    const float* modl = (const float*)(ws + WS_MOD) + (size_t)l * BATCH * NMOD;
    const int shift_off = (MODE == 2) ? 3 * DM : 0;
    LAS float* wg = (LAS float*)lds;
    if (MODE == 0) {
        const float* wgate = ARG_IN(I_WIN) + (size_t)li * DM * NIN;
        __syncthreads();
        for (int i = tid; i < DM * NFX; i += 512) { const int k = i >> 3, j = i & 7; wg[j * DM + k] = wgate[(size_t)k * NIN + NQKV + j]; }
        __syncthreads();
    }
    const int gw = bid * NWAVES + wave, NGW = G * NWAVES;
    bf16* Hb = (bf16*)(ws + WS_H); float* rstd_o = (float*)(ws + WS_RSTD); float* flog = (float*)(ws + WS_FLOG);
    for (int rb = gw; rb < M / 4; rb += NGW) {
        const int m0 = rb * 4, b = m0 / SEQ;
        f32x4 gv[8], sh[8];
        if (MODE != 1) {
#pragma unroll
            for (int j = 0; j < 8; ++j) { const int cidx = (lane + 64 * j) * 4;
                gv[j] = *(const GAS f32x4*)(gain + cidx);
                if (MODE != 3) { const f32x4 sc = *(const GAS f32x4*)(modl + (size_t)b * NMOD + shift_off + DM + cidx); gv[j] = gv[j] * (sc + 1.0f);
                                 sh[j] = *(const GAS f32x4*)(modl + (size_t)b * NMOD + shift_off + cidx); } }
        }
        for (int rr = 0; rr < 4; ++rr) {
            const int m = m0 + rr;
            const GAS f32x4* xr = (const GAS f32x4*)(x + (size_t)m * DM) + lane;
            f32x4 v[8]; float ss = 0.f;
#pragma unroll
            for (int j = 0; j < 8; ++j) { v[j] = xr[64 * j]; ss += (v[j].x * v[j].x + v[j].y * v[j].y) + (v[j].z * v[j].z + v[j].w * v[j].w); }
            const float rstd = 1.0f / sqrtf(wave_sum(ss) * (1.0f / DM) + EPS);
            if (MODE == 1) { if (lane == 0) rstd_o[m] = rstd; continue; }
            if (MODE == 3) {
                GAS f32x4* o = (GAS f32x4*)(ARG_OUT() + (size_t)m * DM) + lane;
#pragma unroll
                for (int j = 0; j < 8; ++j) o[64 * j] = v[j] * rstd * gv[j];
                continue;
            }
#pragma unroll
            for (int j = 0; j < 8; ++j) v[j] = v[j] * rstd * gv[j] + sh[j];
            GAS v2u* o8 = (GAS v2u*)(Hb + (size_t)m * LDH) + lane;
#pragma unroll
            for (int j = 0; j < 8; ++j) { v2u w; w.x = pk2(v[j].x, v[j].y); w.y = pk2(v[j].z, v[j].w); o8[64 * j] = w; }
            if (MODE == 0) {
                float g8[8];
#pragma unroll
                for (int q = 0; q < 8; ++q) { float a = 0.f;
#pragma unroll
                    for (int j = 0; j < 8; ++j) { const f32x4 w = *(const LAS f32x4*)(wg + q * DM + (lane + 64 * j) * 4); a += (v[j].x * w.x + v[j].y * w.y) + (v[j].z * w.z + v[j].w * w.w); }
                    g8[q] = wave_sum(a); }
                if (lane < 8) { float f = 0.f;
#pragma unroll
                    for (int q = 0; q < 8; ++q) f = (lane == q) ? g8[q] : f;
                    f += ARG_IN(I_BF)[li * NFX + lane];
                    const float ls = fminf(f, 0.f) - log1pf(expf(-fabsf(f)));
                    flog[((size_t)b * NFX + lane) * SEQ + (m - b * SEQ)] = ls; }
            }
        }
    }
}

__device__ __forceinline__ void pooldiff_phase(const Args& args, const int wv, int l) {
    PHASE_LOCALS;
    const float* x = (const float*)ARG_OUT();
    const float* gain = ARG_IN(I_GAIN) + (size_t)(l * 2) * DM;
    const float* modl = (const float*)(ws + WS_MOD) + (size_t)l * BATCH * NMOD;
    const int gw = bid * NWAVES + wave, NGW = G * NWAVES;
    const float* rstd = (const float*)(ws + WS_RSTD); bf16* Hb = (bf16*)(ws + WS_H);
    for (int it = gw; it < (M / 16) * 4; it += NGW) {
        const int grp = it & 3, chunk = it >> 2, t0 = chunk * 16, b = t0 / SEQ, tp0 = t0 - b * SEQ;
        const int w = 2 << grp;
        const int col = grp * 512 + lane * 8;
        f32x4 g0 = *(const GAS f32x4*)(gain + col), g1 = *(const GAS f32x4*)(gain + col + 4);
        g0 = g0 * (*(const GAS f32x4*)(modl + (size_t)b * NMOD + DM + col) + 1.0f); g1 = g1 * (*(const GAS f32x4*)(modl + (size_t)b * NMOD + DM + col + 4) + 1.0f);
        f32x4 s0 = {0.f, 0.f, 0.f, 0.f}, s1 = {0.f, 0.f, 0.f, 0.f};
        int tstart = tp0 - w; if (tstart < 0) tstart = 0;
        for (int tp = tstart; tp < tp0; ++tp) { const size_t m = (size_t)b * SEQ + tp; const float r = rstd[m];
            s0 = s0 + *(const GAS f32x4*)(x + m * DM + col) * r; s1 = s1 + *(const GAS f32x4*)(x + m * DM + col + 4) * r; }
        for (int i = 0; i < 16; ++i) { const int tp = tp0 + i; const size_t m = (size_t)b * SEQ + tp; const float r = rstd[m];
            const f32x4 y0 = *(const GAS f32x4*)(x + m * DM + col) * r, y1 = *(const GAS f32x4*)(x + m * DM + col + 4) * r;
            s0 = s0 + y0; s1 = s1 + y1;
            if (tp >= w) { const size_t mo = m - w; const float ro = rstd[mo];
                s0 = s0 - *(const GAS f32x4*)(x + mo * DM + col) * ro; s1 = s1 - *(const GAS f32x4*)(x + mo * DM + col + 4) * ro; }
            const float inv = 1.0f / (float)((tp + 1 < w) ? (tp + 1) : w);
            const f32x4 d0 = (s0 * inv - y0) * g0, d1 = (s1 * inv - y1) * g1;
            v4u o; o.x = pk2(d0.x, d0.y); o.y = pk2(d0.z, d0.w); o.z = pk2(d1.x, d1.y); o.w = pk2(d1.z, d1.w);
            *(GAS v4u*)(Hb + m * LDH + col) = o; }
    }
}

__device__ __forceinline__ void convgate_phase(const Args& args, const int wv, int l) {
    PHASE_LOCALS;
    const float* cw = ARG_IN(I_CONVW) + (size_t)l * 3 * F2; const float* cb = ARG_IN(I_CONVB) + (size_t)l * F2;
    const int gw = bid * NWAVES + wave, NGW = G * NWAVES;
    const bf16* U = (const bf16*)(ws + WS_U); bf16* A = (bf16*)(ws + WS_ACT);
    constexpr int NCB = DFF / 512;
    for (int it = gw; it < (M / 16) * NCB; it += NGW) {
        const int cbk = it % NCB, chunk = it / NCB, t0 = chunk * 16, tp0 = t0 % SEQ;
        const int col = cbk * 512 + lane * 8;
        float wa[3][8], wgt[3][8], ba[8], bg[8];
#pragma unroll
        for (int i = 0; i < 3; ++i) {
            const f32x4 a0 = *(const GAS f32x4*)(cw + (size_t)i * F2 + col), a1 = *(const GAS f32x4*)(cw + (size_t)i * F2 + col + 4);
            const f32x4 b0 = *(const GAS f32x4*)(cw + (size_t)i * F2 + DFF + col), b1 = *(const GAS f32x4*)(cw + (size_t)i * F2 + DFF + col + 4);
            wa[i][0] = a0.x; wa[i][1] = a0.y; wa[i][2] = a0.z; wa[i][3] = a0.w; wa[i][4] = a1.x; wa[i][5] = a1.y; wa[i][6] = a1.z; wa[i][7] = a1.w;
            wgt[i][0] = b0.x; wgt[i][1] = b0.y; wgt[i][2] = b0.z; wgt[i][3] = b0.w; wgt[i][4] = b1.x; wgt[i][5] = b1.y; wgt[i][6] = b1.z; wgt[i][7] = b1.w; }
        { const f32x4 a0 = *(const GAS f32x4*)(cb + col), a1 = *(const GAS f32x4*)(cb + col + 4), b0 = *(const GAS f32x4*)(cb + DFF + col), b1 = *(const GAS f32x4*)(cb + DFF + col + 4);
          ba[0] = a0.x; ba[1] = a0.y; ba[2] = a0.z; ba[3] = a0.w; ba[4] = a1.x; ba[5] = a1.y; ba[6] = a1.z; ba[7] = a1.w;
          bg[0] = b0.x; bg[1] = b0.y; bg[2] = b0.z; bg[3] = b0.w; bg[4] = b1.x; bg[5] = b1.y; bg[6] = b1.z; bg[7] = b1.w; }
        v4u pa2 = {0u, 0u, 0u, 0u}, pa1 = {0u, 0u, 0u, 0u}, pg2 = {0u, 0u, 0u, 0u}, pg1 = {0u, 0u, 0u, 0u};
        if (tp0 >= 2) { const bf16* r2 = U + (size_t)(t0 - 2) * LDU + col; const bf16* r1 = U + (size_t)(t0 - 1) * LDU + col;
            pa2 = *(const GAS v4u*)r2; pg2 = *(const GAS v4u*)(r2 + DFF); pa1 = *(const GAS v4u*)r1; pg1 = *(const GAS v4u*)(r1 + DFF); }
#pragma unroll 4
        for (int i = 0; i < 16; ++i) {
            const bf16* r0 = U + (size_t)(t0 + i) * LDU + col;
            const v4u ca = *(const GAS v4u*)r0, cg = *(const GAS v4u*)(r0 + DFF);
            unsigned ow[4];
#pragma unroll
            for (int q = 0; q < 4; ++q) {
                const float ya0 = ba[2 * q] + wa[0][2 * q] * bflo(pa2[q]) + wa[1][2 * q] * bflo(pa1[q]) + wa[2][2 * q] * bflo(ca[q]);
                const float ya1 = ba[2 * q + 1] + wa[0][2 * q + 1] * bfhi(pa2[q]) + wa[1][2 * q + 1] * bfhi(pa1[q]) + wa[2][2 * q + 1] * bfhi(ca[q]);
                const float yg0 = bg[2 * q] + wgt[0][2 * q] * bflo(pg2[q]) + wgt[1][2 * q] * bflo(pg1[q]) + wgt[2][2 * q] * bflo(cg[q]);
                const float yg1 = bg[2 * q + 1] + wgt[0][2 * q + 1] * bfhi(pg2[q]) + wgt[1][2 * q + 1] * bfhi(pg1[q]) + wgt[2][2 * q + 1] * bfhi(cg[q]);
                ow[q] = pk2(silu_f(yg0) * ya0, silu_f(yg1) * ya1); }
            v4u o; o.x = ow[0]; o.y = ow[1]; o.z = ow[2]; o.w = ow[3];
            *(GAS v4u*)(A + (size_t)(t0 + i) * LDACT + col) = o;
            pa2 = pa1; pa1 = ca; pg2 = pg1; pg1 = cg;
        }
    }
}

namespace att {
constexpr int KVBLK = 64, QBLK = 32, QB = 256, SHM_V = KVBLK * HD * 2, SHM_K = KVBLK * HD * 2;
constexpr int OFF_V = 0, OFF_K = 2 * SHM_V, OFF_FS = 65536, OFF_WS = OFF_FS + 8192, OFF_FLAGS = OFF_WS + 2048, OFF_SCAN = OFF_FLAGS + 64, ATT_LDS = OFF_SCAN + 64;
#define KSWZ(row, colB) ((row) * 256 + ((colB) ^ (((row) & 7) << 4)))
#define SBAR() __builtin_amdgcn_sched_barrier(0)
__device__ __forceinline__ int v_st(int k, int c) { const int kk = (k & ~0xC) | ((k & 4) << 1) | ((k & 8) >> 1); return ((kk >> 3) * 4 + (c >> 5)) * 512 + ((kk & 7) * 32 + (c & 31)) * 2; }
__device__ __forceinline__ int v_rd_base(int lane) { return ((lane & 3) << 3) | (((lane >> 2) & 3) << 6) | (((lane >> 4) & 1) << 5) | (((lane >> 5) & 1) << 8); }
constexpr int v_rd_off(int d0, int ks, int half) { return d0 * 512 + ks * 4096 + half * 2048; }
__device__ __forceinline__ int crow(int r, int hi) { return (r & 3) + 8 * (r >> 2) + 4 * hi; }
__device__ __forceinline__ unsigned cvtpk(float lo, float hi) { unsigned r; asm volatile("v_cvt_pk_bf16_f32 %0, %1, %2" : "=v"(r) : "v"(lo), "v"(hi)); return r; }

__device__ __forceinline__ void qkt(f32x16& p0, f32x16& p1, const LAS unsigned char* kbase, int r32, int hi, const bf16x8* qr) {
    p0 = f32x16{}; p1 = f32x16{};
    const LAS unsigned char* kb[4];
#pragma unroll
    for (int dd = 0; dd < 4; ++dd) kb[dd] = kbase + KSWZ(r32, (dd * 16 + hi * 8) * 2);
#pragma unroll
    for (int d0 = 0; d0 < 8; ++d0) { const LAS unsigned char* a = kb[d0 & 3] + (d0 >> 2) * 128;
        const bf16x8 b0 = *(const LAS bf16x8*)a;
        const bf16x8 b1 = *(const LAS bf16x8*)(a + 32 * 256);
        p0 = __builtin_amdgcn_mfma_f32_32x32x16_bf16(b0, qr[d0], p0, 0, 0, 0);
        p1 = __builtin_amdgcn_mfma_f32_32x32x16_bf16(b1, qr[d0], p1, 0, 0, 0); }
}
__device__ __forceinline__ void pv_tile(f32x16* o, unsigned vb0, bf16x8 pa0, bf16x8 pa1, bf16x8 pa2, bf16x8 pa3) {
#define TRRD(dst, off) asm volatile("ds_read_b64_tr_b16 %0, %1 offset:%2" : "=&v"(dst) : "v"(vb0), "i"(off) : "memory")
#define PV_D0(d0) do { s16x4 l0, l1, l2, l3, h0, h1, h2, h3; constexpr int b_ = v_rd_off(d0, 0, 0); \
        TRRD(l0, b_); TRRD(h0, b_ + 2048); TRRD(l1, b_ + 4096); TRRD(h1, b_ + 6144); TRRD(l2, b_ + 8192); TRRD(h2, b_ + 10240); TRRD(l3, b_ + 12288); TRRD(h3, b_ + 14336); \
        asm volatile("s_waitcnt lgkmcnt(0)" ::: "memory"); SBAR(); \
        o[d0] = __builtin_amdgcn_mfma_f32_32x32x16_bf16(pa0, (bf16x8){l0[0], l0[1], l0[2], l0[3], h0[0], h0[1], h0[2], h0[3]}, o[d0], 0, 0, 0); \
        o[d0] = __builtin_amdgcn_mfma_f32_32x32x16_bf16(pa1, (bf16x8){l1[0], l1[1], l1[2], l1[3], h1[0], h1[1], h1[2], h1[3]}, o[d0], 0, 0, 0); \
        o[d0] = __builtin_amdgcn_mfma_f32_32x32x16_bf16(pa2, (bf16x8){l2[0], l2[1], l2[2], l2[3], h2[0], h2[1], h2[2], h2[3]}, o[d0], 0, 0, 0); \
        o[d0] = __builtin_amdgcn_mfma_f32_32x32x16_bf16(pa3, (bf16x8){l3[0], l3[1], l3[2], l3[3], h3[0], h3[1], h3[2], h3[3]}, o[d0], 0, 0, 0); } while (0)
    PV_D0(0); PV_D0(1); PV_D0(2); PV_D0(3);
#undef PV_D0
#undef TRRD
}
#define PK4(P, B_, OUT) do { unsigned a0 = cvtpk(P[B_+0], P[B_+1]), a1 = cvtpk(P[B_+2], P[B_+3]); \
        unsigned b0 = cvtpk(P[B_+4], P[B_+5]), b1 = cvtpk(P[B_+6], P[B_+7]); \
        auto r0 = __builtin_amdgcn_permlane32_swap(a0, b0, false, false); auto r1 = __builtin_amdgcn_permlane32_swap(a1, b1, false, false); \
        v4u w = {r0[0], r1[0], r0[1], r1[1]}; OUT = __builtin_bit_cast(bf16x8, w); } while (0)

template <bool FOX>
__device__ __forceinline__ void unit(LAS unsigned char* lds, const bf16* Q, const bf16* K, const bf16* V, bf16* O, const float* flog_bh, int b, int h, int qb, const int tid) {
    const int wid = __builtin_amdgcn_readfirstlane(tid >> 6), lane = tid & 63, r32 = lane & 31, hi = lane >> 5;
    const size_t rowbase = (size_t)b * SEQ;
    const int P0 = qb * QB, qlo = P0 + wid * QBLK, tpos = qlo + r32;
    LAS float* Fs = (LAS float*)(lds + OFF_FS);
    LAS float* wsf = (LAS float*)(lds + OFF_WS) + wid * 64; LAS float* li_l = wsf; LAS float* al_l = wsf + 32;
    volatile LAS int* flags = (volatile LAS int*)(lds + OFF_FLAGS);
    LAS float* scanp = (LAS float*)(lds + OFF_SCAN);
    const unsigned ldsb = (unsigned)(uintptr_t)lds;
    __syncthreads();
    if (FOX) {
        f32x4 v = *(const GAS f32x4*)(flog_bh + 4 * tid);
        v.y += v.x; v.z += v.y; v.w += v.z;
        float inc = v.w;
#pragma unroll
        for (int o = 1; o < 64; o <<= 1) { const float t = __shfl_up(inc, o); if (lane >= o) inc += t; }
        if (lane == 63) scanp[wid] = inc;
        __syncthreads();
        float off = inc - v.w;
#pragma unroll
        for (int w = 0; w < 8; ++w) off += (w < wid) ? scanp[w] : 0.f;
        *(LAS f32x4*)(Fs + 4 * tid) = (v + off) * LOG2E;
    }
    bf16x8 qr[8];
    { const bf16* qp = Q + (rowbase + tpos) * LDH + h * HD + hi * 8;
#pragma unroll
      for (int d0 = 0; d0 < 8; ++d0) qr[d0] = *(const GAS bf16x8*)(qp + d0 * 16); }
    const int sr = tid >> 4, sc = (tid & 15) * 8;
    const unsigned vst0 = v_st(sr, sc), vst1 = v_st(32 + sr, sc), kws = KSWZ(sr, sc * 2);
    const bf16* Kh = K + rowbase * LDH + h * HD + sc; const bf16* Vh = V + rowbase * LDH + h * HD + sc;
    const unsigned vrd = ldsb + OFF_V + v_rd_base(lane);
    bf16x8 st_k0, st_k1, st_v0, st_v1;
#define SLOAD(k0) do { st_k0 = *(const GAS bf16x8*)(Kh + (size_t)((k0) + sr) * LDH); st_k1 = *(const GAS bf16x8*)(Kh + (size_t)((k0) + 32 + sr) * LDH); \
                       st_v0 = *(const GAS bf16x8*)(Vh + (size_t)((k0) + sr) * LDH); st_v1 = *(const GAS bf16x8*)(Vh + (size_t)((k0) + 32 + sr) * LDH); } while (0)
#define SWRITE(bf) do { *(LAS bf16x8*)(lds + OFF_K + (bf) * SHM_K + kws) = st_k0; *(LAS bf16x8*)(lds + OFF_K + (bf) * SHM_K + kws + 32 * 256) = st_k1; \
                        *(LAS bf16x8*)(lds + OFF_V + (bf) * SHM_V + vst0) = st_v0; *(LAS bf16x8*)(lds + OFF_V + (bf) * SHM_V + vst1) = st_v1; } while (0)
    int jt = (P0 + QB - 1) / KVBLK;
    SLOAD(jt * KVBLK); VM_WAIT(); SWRITE(0);
    __syncthreads();
    f32x16 o[4] = {};
    float m_reg = -1e30f, l_reg = 0.f, R = 1.0f;
    const float Ft2 = FOX ? Fs[tpos] : 0.f;
    constexpr float C2 = LOG2E * ATT_SCALE;
    int buf = 0, it = 0; bool wdone = false;
    for (;;) {
        const int kb = jt * KVBLK;
        const bool more = jt > 0;
        if (more) SLOAD(kb - KVBLK);
        const bool act = FOX ? (kb <= qlo + QBLK - 1) : (kb <= qlo + QBLK - 2 && !wdone);
        if (act) {
            f32x16 p0, p1;
            qkt(p0, p1, lds + OFF_K + buf * SHM_K, r32, hi, qr);
            bf16x8 pa0, pa1, pa2, pa3;
            if (FOX) {
#pragma unroll
                for (int g = 0; g < 4; ++g) { const f32x4 f0 = *(const LAS f32x4*)(Fs + kb + 8 * g + 4 * hi), f1 = *(const LAS f32x4*)(Fs + kb + 32 + 8 * g + 4 * hi);
#pragma unroll
                    for (int e = 0; e < 4; ++e) { p0[4 * g + e] = fmaf(p0[4 * g + e], C2, Ft2 - f0[e]); p1[4 * g + e] = fmaf(p1[4 * g + e], C2, Ft2 - f1[e]); } }
                if (kb + KVBLK - 1 > qlo) {
                    const float NEG = -__builtin_inff(); const int dq = tpos - kb - 4 * hi;
#pragma unroll
                    for (int r = 0; r < 16; ++r) { const int c = (r & 3) + 8 * (r >> 2); if (c > dq) p0[r] = NEG; if (c + 32 > dq) p1[r] = NEG; }
                }
                float pmax = p0[0];
#pragma unroll
                for (int r = 1; r < 16; ++r) pmax = fmaxf(pmax, p0[r]);
#pragma unroll
                for (int r = 0; r < 16; ++r) pmax = fmaxf(pmax, p1[r]);
                { auto rr = __builtin_amdgcn_permlane32_swap(__float_as_uint(pmax), __float_as_uint(pmax), false, false); pmax = fmaxf(__uint_as_float(rr[0]), __uint_as_float(rr[1])); }
                const float mn = fmaxf(m_reg, pmax); const float alpha = __builtin_amdgcn_exp2f(m_reg - mn); m_reg = mn;
                float ps = 0.f;
#pragma unroll
                for (int r = 0; r < 16; ++r) { p0[r] = __builtin_amdgcn_exp2f(p0[r] - mn); p1[r] = __builtin_amdgcn_exp2f(p1[r] - mn); ps += p0[r] + p1[r]; }
                { auto rr = __builtin_amdgcn_permlane32_swap(__float_as_uint(ps), __float_as_uint(ps), false, false); ps = __uint_as_float(rr[0]) + __uint_as_float(rr[1]); }
                l_reg = l_reg * alpha + ps;
                if (__any(alpha < 1.f)) { if (hi == 0) al_l[r32] = alpha; LDS_WAIT();
#pragma unroll
                    for (int r = 0; r < 16; ++r) { const float a = al_l[crow(r, hi)];
#pragma unroll
                        for (int d_ = 0; d_ < 4; ++d_) o[d_][r] *= a; } }
            } else {
                const int dq = tpos - kb - 4 * hi;
                const bool needmask = (kb + KVBLK - 1 >= qlo);
#pragma unroll
                for (int r = 0; r < 16; ++r) { const int c = (r & 3) + 8 * (r >> 2);
                    const float u0 = __builtin_amdgcn_exp2f(fminf(p0[r] * C2, 115.f)), u1 = __builtin_amdgcn_exp2f(fminf(p1[r] * C2, 115.f));
                    float r0 = __builtin_amdgcn_rcpf(1.0f + u0), r1 = __builtin_amdgcn_rcpf(1.0f + u1);
                    if (needmask) { if (c >= dq) r0 = 1.0f; if (c + 32 >= dq) r1 = 1.0f; }
                    p0[r] = r0; p1[r] = r1; }
                float og[8], pg[8];
#pragma unroll
                for (int i = 0; i < 4; ++i) { og[i] = (p0[4 * i] * p0[4 * i + 1]) * (p0[4 * i + 2] * p0[4 * i + 3]); og[4 + i] = (p1[4 * i] * p1[4 * i + 1]) * (p1[4 * i + 2] * p1[4 * i + 3]); }
#pragma unroll
                for (int i = 0; i < 8; ++i) { auto rr = __builtin_amdgcn_permlane32_swap(__float_as_uint(og[i]), __float_as_uint(og[i]), false, false);
                    pg[i] = hi ? __uint_as_float(rr[0]) : __uint_as_float(rr[1]); }
                float Srun = R;
#pragma unroll
                for (int j = 7; j >= 0; --j) {
                    const float ex = hi ? Srun : Srun * pg[j];
                    Srun = Srun * og[j] * pg[j];
                    if (j >= 4) { const int i = j - 4; const float e3 = ex, e2 = e3 * p1[4 * i + 3], e1 = e2 * p1[4 * i + 2], e0 = e1 * p1[4 * i + 1];
                        p1[4 * i] = (1.0f - p1[4 * i]) * e0; p1[4 * i + 1] = (1.0f - p1[4 * i + 1]) * e1; p1[4 * i + 2] = (1.0f - p1[4 * i + 2]) * e2; p1[4 * i + 3] = (1.0f - p1[4 * i + 3]) * e3; }
                    else { const int i = j; const float e3 = ex, e2 = e3 * p0[4 * i + 3], e1 = e2 * p0[4 * i + 2], e0 = e1 * p0[4 * i + 1];
                        p0[4 * i] = (1.0f - p0[4 * i]) * e0; p0[4 * i + 1] = (1.0f - p0[4 * i + 1]) * e1; p0[4 * i + 2] = (1.0f - p0[4 * i + 2]) * e2; p0[4 * i + 3] = (1.0f - p0[4 * i + 3]) * e3; }
                }
                R = Srun;
                wdone = __all(R < SB_EXIT);
            }
            PK4(p0, 0, pa0); PK4(p0, 8, pa1); PK4(p1, 0, pa2); PK4(p1, 8, pa3);
            pv_tile(o, vrd + buf * SHM_V, pa0, pa1, pa2, pa3);
        }
        if (!FOX) { if (lane == 0) flags[(it & 1) * 8 + wid] = wdone ? 1 : 0; }
        if (more) { VM_WAIT(); SWRITE(buf ^ 1); }
        __syncthreads();
        if (!more) break;
        if (!FOX) { int alld = 1;
#pragma unroll
            for (int w = 0; w < 8; ++w) alld &= flags[(it & 1) * 8 + w];
            if (alld) break; }
        buf ^= 1; --jt; ++it;
    }
#undef SLOAD
#undef SWRITE
    float rli[16];
    if (FOX) { if (hi == 0) li_l[r32] = l_reg; LDS_WAIT();
#pragma unroll
        for (int r = 0; r < 16; ++r) rli[r] = __builtin_amdgcn_rcpf(li_l[crow(r, hi)]); }
    bf16* Ow = O + (rowbase + qlo) * LDH + h * HD;
#pragma unroll
    for (int r = 0; r < 16; ++r) { const int orow = crow(r, hi);
#pragma unroll
        for (int d0 = 0; d0 < 4; ++d0) { const float v = FOX ? o[d0][r] * rli[r] : o[d0][r];
            const float vn = __shfl_xor(v, 1);
            if ((r32 & 1) == 0) *(GAS unsigned*)(Ow + (size_t)orow * LDH + d0 * 32 + r32) = cvtpk(v, vn); } }
}
#undef PK4
}

__device__ __forceinline__ void attention_phase(const Args& args, const int wv, LAS unsigned char* lds, int li) {
    PHASE_LOCALS;
    volatile LAS unsigned* MISC = (volatile LAS unsigned*)(lds + MISC_OFF);
    const bf16* Q = (const bf16*)(ws + WS_Q); const bf16* K = (const bf16*)(ws + WS_K); const bf16* V = (const bf16*)(ws + WS_V); bf16* O = (bf16*)(ws + WS_AO);
    const float* flog = (const float*)(ws + WS_FLOG);
    gu32* head = (gu32*)(ws + WS_CTL) + CW_QUEUE + 64 * li;
    for (;;) {
        __syncthreads();
        if (tid == 0) MISC[16] = __hip_atomic_fetch_add(head, 1u, RLX_AGENT);
        __syncthreads();
        const int item = (int)MISC[16];
        if (item >= 512) break;
        const int fox = item < 256 ? 1 : 0, r = item & 255, qb = 7 - (r >> 5), bh = r & 31, b = bh >> 3, h = (bh & 7) + (fox ? NSB : 0);
        if (fox) att::unit<true>(lds, Q, K, V, O, flog + ((size_t)b * NFX + (h - NSB)) * SEQ, b, h, qb, tid);
        else att::unit<false>(lds, Q, K, V, O, flog, b, h, qb, tid);
    }
}

template <int KIND>
__device__ __forceinline__ void gemm_bf16_phase(const Args& args, const int wv, LAS unsigned char* lds, int l) {
    PHASE_LOCALS;
    const bf16* Hb = (const bf16*)(ws + WS_H);
    if (KIND == 0) {
        pg8::Gemm g{Hb, (const bf16*)(ws + WS_WIN + (l >> 1) * SZ_WIN), M, NQKV, DM, LDH, LDW, 0, 256, 128};
        pg8::StaticOrder S; S.init(M, NQKV, G, bid);
        pg8::EpiBf16 E{(bf16*)(ws + WS_Q), LDH, DM, (size_t)(WS_K - WS_Q) / 2, PROBE_SKIP_EPI ? (&args.probe)[zz] : 0};
        pg8::gemm_phase<pg8::EpiBf16, pg8::StaticOrder, true, true>(lds, g, S, E, tid);
    } else {
        pg8::Gemm g{Hb, (const bf16*)(ws + WS_WUP + l * SZ_WUP), M, F2, DM, LDH, LDW, 0, 128, DFF};
        pg8::StaticOrder S; S.init(M, F2, G, bid);
        pg8::EpiConvGate E{(bf16*)(ws + WS_ACT), LDACT, ARG_IN(I_CONVW) + (size_t)l * 3 * F2, ARG_IN(I_CONVB) + (size_t)l * F2, (float*)(ws + WS_EDGE), (LAS float*)(lds + HALO_OFF), F2, DFF};
        pg8::gemm_phase<pg8::EpiConvGate, pg8::StaticOrder, true, true>(lds, g, S, E, tid);
    }
}
__device__ __forceinline__ void gemm_resid_phase(const Args& args, const int wv, LAS unsigned char* lds, int l, int kind) {
    PHASE_LOCALS;
    const int li = l >> 1;
    const float* modl = (const float*)(ws + WS_MOD) + (size_t)l * BATCH * NMOD;
    float* out = ARG_OUT();
    pg8::Gemm g; pg8::EpiResid E{out, (&args.probe)[zz] ? (float*)(ws + WS_U) : out, modl + (kind == 2 ? 5 * DM : 2 * DM), nullptr};
    if (kind == 0) { g = pg8::Gemm{(const bf16*)(ws + WS_AO), (const bf16*)(ws + WS_WOUT + li * SZ_WOUT), M, DM, DM, LDH, LDW, 0, 256, 128}; if (l == 0) E.xin = ARG_IN(I_X); }
    else if (kind == 1) { g = pg8::Gemm{(const bf16*)(ws + WS_H), (const bf16*)(ws + WS_WPOOL + li * SZ_WPOOL), M, DM, 512, LDH, LDWP, 1, 256, 128}; E.pscale = ARG_IN(I_PSCALE) + (size_t)li * DM; }
    else g = pg8::Gemm{(const bf16*)(ws + WS_ACT), (const bf16*)(ws + WS_WDOWN + l * SZ_WDOWN), M, DM, DFF, LDACT, LDWD, 0, 256, 128};
    pg8::StaticOrder S; S.init(M, DM, G, bid);
    if (kind == 2) {
        const float* cw = ARG_IN(I_CONVW) + (size_t)l * 3 * F2; const float* cb = ARG_IN(I_CONVB) + (size_t)l * F2;
        const float* edge = (const float*)(ws + WS_EDGE); bf16* ACT = (bf16*)(ws + WS_ACT);
        pg8::Unit u0;
        for (int ui = 0; S.next(ui, u0); ++ui) {
            if ((u0.pm & 7) == 0) continue;
            const float* ep = edge + (size_t)(u0.pm - 1) * 8 * DFF;
            for (int q = tid; q < DFF / 4; q += 512) { const int col = q * 4;
                f32x4 ua[4], ug[4];
                ua[0] = *(const GAS f32x4*)(ep + (2 * 2 + 0) * DFF + col); ug[0] = *(const GAS f32x4*)(ep + (2 * 2 + 1) * DFF + col);
                ua[1] = *(const GAS f32x4*)(ep + (3 * 2 + 0) * DFF + col); ug[1] = *(const GAS f32x4*)(ep + (3 * 2 + 1) * DFF + col);
                ua[2] = *(const GAS f32x4*)(ep + (4 * 2 + 0) * DFF + col); ug[2] = *(const GAS f32x4*)(ep + (4 * 2 + 1) * DFF + col);
                ua[3] = *(const GAS f32x4*)(ep + (5 * 2 + 0) * DFF + col); ug[3] = *(const GAS f32x4*)(ep + (5 * 2 + 1) * DFF + col);
                const f32x4 w0a = *(const GAS f32x4*)(cw + col), w1a = *(const GAS f32x4*)(cw + F2 + col), w2a = *(const GAS f32x4*)(cw + 2 * F2 + col), ba = *(const GAS f32x4*)(cb + col);
                const f32x4 w0g = *(const GAS f32x4*)(cw + DFF + col), w1g = *(const GAS f32x4*)(cw + F2 + DFF + col), w2g = *(const GAS f32x4*)(cw + 2 * F2 + DFF + col), bg = *(const GAS f32x4*)(cb + DFF + col);
#pragma unroll
                for (int rr = 0; rr < 2; ++rr) {
                    const f32x4 ya = ba + w0a * ua[rr] + w1a * ua[rr + 1] + w2a * ua[rr + 2], yg = bg + w0g * ug[rr] + w1g * ug[rr + 1] + w2g * ug[rr + 2];
                    float o[4];
#pragma unroll
                    for (int e = 0; e < 4; ++e) o[e] = ya[e] * yg[e] * __builtin_amdgcn_rcpf(1.0f + __expf(-yg[e]));
                    v2u w; w.x = pk2(o[0], o[1]); w.y = pk2(o[2], o[3]);
                    *(GAS v2u*)(ACT + (size_t)(u0.pm * 256 + rr) * LDACT + col) = w; }
            }
        }
        VM_WAIT(); __syncthreads();
    }
    pg8::gemm_phase<pg8::EpiResid, pg8::StaticOrder, false, true>(lds, g, S, E, tid);
}

#ifndef EN_MASK
#define EN_MASK 0xffff
#endif
#define EN(b) ((EN_MASK >> (b)) & 1)
constexpr int NPHASES = 2 + DEPTH * 8 + 1;
__global__ void __launch_bounds__(NWAVES * 64, 2) fwd_kernel(Args args) {
    extern __shared__ __attribute__((aligned(16))) unsigned char lds_raw[];
    LAS unsigned char* lds = (LAS unsigned char*)lds_raw;
    volatile LAS unsigned* MISC = (volatile LAS unsigned*)(lds + MISC_OFF);
    if (threadIdx.x < 32) MISC[threadIdx.x] = 0u;
    __syncthreads();
    const int wv = __builtin_amdgcn_readfirstlane((int)threadIdx.x >> 6);
    if (MK_N_LAUNCHES == 1) (void)xcd_barrier_post((unsigned*)(args.ws + WS_CTL) + CW_BAR, MISC + 8);
#define PH_LO() ((&args.ph_lo)[opaque_zero()])
#define PH_HI() ((&args.ph_hi)[opaque_zero()])
#define IN(k) (PH_LO() <= (k) && (k) < PH_HI())
#define SEAM(k) do { if (IN(k) && IN((k) + 1)) { XcdBarrier bb_; bb_.bar = (unsigned*)((&args.ws)[opaque_zero()] + WS_CTL) + CW_BAR; bb_.x = xb_xcc_id(); \
        bb_.st = (volatile LAS unsigned*)(lds + MISC_OFF) + 8; xcd_barrier(bb_); } } while (0)

    if (EN(0) && IN(0)) p0_prologue(args, wv, lds);
    SEAM(0);
    if (EN(1) && IN(1)) p0b_modreduce(args, wv);
    SEAM(1);

    for (int l = 0; l < DEPTH; ++l) {
        const int pb = 2 + l * 8; const bool attn = (l & 1) == 0;
        if (EN(2) && IN(pb + 0)) { if (attn) norm_phase<0>(args, wv, lds, l); else norm_phase<1>(args, wv, lds, l); }
        SEAM(pb + 0);
        if (EN(3) && IN(pb + 1)) { if (attn) gemm_bf16_phase<0>(args, wv, lds, l); else pooldiff_phase(args, wv, l); }
        SEAM(pb + 1);
        if (EN(4) && IN(pb + 2)) { if (attn) attention_phase(args, wv, lds, l >> 1); }
        if (attn) SEAM(pb + 2);
        if (EN(5) && IN(pb + 3)) gemm_resid_phase(args, wv, lds, l, attn ? 0 : 1);
        SEAM(pb + 3);
        if (EN(6) && IN(pb + 4)) norm_phase<2>(args, wv, lds, l);
        SEAM(pb + 4);
        if (EN(7) && IN(pb + 5)) gemm_bf16_phase<1>(args, wv, lds, l);
        SEAM(pb + 5);
        if (EN(9) && IN(pb + 7)) gemm_resid_phase(args, wv, lds, l, 2);
        SEAM(pb + 7);
    }
    if (EN(10) && IN(NPHASES - 1)) norm_phase<3>(args, wv, lds, 0);
#undef IN
#undef SEAM
}

extern "C" void kernel_launch(void* const* d_in, const int* in_sizes, int n_in, void* d_out, int out_size, void* d_ws, size_t ws_size, hipStream_t stream) {
    static int grid = 0;
    if (grid == 0) {
        if (n_in != 15 || in_sizes[0] != M * DM || out_size != M * DM || ws_size < WS_END) { fprintf(stderr, "kernel_launch: unexpected shapes (n_in %d, in0 %d, out %d, ws %zu)\n", n_in, n_in > 0 ? in_sizes[0] : -1, out_size, ws_size); grid = -1; return; }
        int dev = 0, cus = 0, per_cu = 0;
        if (hipGetDevice(&dev) != hipSuccess || hipDeviceGetAttribute(&cus, hipDeviceAttributeMultiprocessorCount, dev) != hipSuccess) { grid = -1; return; }
        if (hipFuncSetAttribute((const void*)fwd_kernel, hipFuncAttributeMaxDynamicSharedMemorySize, LDS_BYTES) != hipSuccess) { fprintf(stderr, "kernel_launch: hipFuncSetAttribute failed\n"); grid = -1; return; }
        if (hipOccupancyMaxActiveBlocksPerMultiprocessor(&per_cu, (const void*)fwd_kernel, NWAVES * 64, LDS_BYTES) != hipSuccess || per_cu < 1) { fprintf(stderr, "kernel_launch: occupancy query says %d\n", per_cu); }
        (void)hipGetLastError();
        grid = cus;
    }
    if (grid < 0) return;
    (void)hipMemsetAsync((char*)d_ws + WS_CTL, 0, CTL_ZERO_BYTES, stream);
    Args a{};
    for (int i = 0; i < 15; ++i) a.in[i] = (const float*)d_in[i];
    a.out = (float*)d_out; a.ws = (unsigned char*)d_ws;
#if MK_N_LAUNCHES == 1
    a.ph_lo = 0; a.ph_hi = NPHASES;
    hipLaunchKernelGGL(fwd_kernel, dim3(grid), dim3(NWAVES * 64), LDS_BYTES, stream, a);
#else
    for (int p = 0; p < NPHASES; ++p) { a.ph_lo = p; a.ph_hi = p + 1; a.probe = 0;
        const int kind = p < 2 ? p : (p == NPHASES - 1 ? 10 : 2 + (p - 2) % 8);
        const bool dbl = (PROBE_MASK >> kind) & 1;
        if (dbl) { a.probe = 1; hipLaunchKernelGGL(fwd_kernel, dim3(grid), dim3(NWAVES * 64), LDS_BYTES, stream, a); a.probe = 0;
                   if (kind == 4) (void)hipMemsetAsync((char*)d_ws + WS_CTL + CW_QUEUE * 4, 0, 1024, stream); }
        hipLaunchKernelGGL(fwd_kernel, dim3(grid), dim3(NWAVES * 64), LDS_BYTES, stream, a); }
#endif
}
```
